# Optimizing an MI355X kernel written in HIP

```python
import jax, jax.numpy as jnp
from jax import lax
import numpy as np

D_MODEL = 1024
BATCH = 32
SEQ = 2048
DEPTH = 4

GRID_W = 64
CTX_LEN = 256
HEAD_DIM = 64
ROPE_THETA = 10000.0
A_HEADS = 6
A_KV_HEADS = 2
B_CH = 256
CONV_W = 31
C_HEADS = 6
C_KV_HEADS = 2
WINDOW = 128
BLOCK = 128
A_Q = A_HEADS * HEAD_DIM
A_KV = A_KV_HEADS * HEAD_DIM
C_Q = C_HEADS * HEAD_DIM
C_KV = C_KV_HEADS * HEAD_DIM
D_MIX = A_Q + B_CH + C_Q
D_IN = A_Q + 2 * A_KV + 2 * B_CH + C_Q + 2 * C_KV
N_GROUPS = 4
EXPERTS_PER_GROUP = 8
N_EXPERTS = N_GROUPS * EXPERTS_PER_GROUP
TOP_K = 2
D_EXPERT = 512
MOE_CHUNK = 256
N_MOD = 6
EPS = 1e-6
ATTN_SCALE = HEAD_DIM ** -0.5

kernel_name = "hymba_diffusion_hybrid_hmoe"


def rms_norm(x, g):
    xf = x.astype(jnp.float32)
    y = xf * lax.rsqrt(jnp.mean(xf * xf, axis=-1, keepdims=True) + EPS)
    return (y * g.astype(jnp.float32)).astype(x.dtype)


def layer_norm(x, g, b):
    xf = x.astype(jnp.float32)
    mu = jnp.mean(xf, axis=-1, keepdims=True)
    xc = xf - mu
    var = jnp.mean(xc * xc, axis=-1, keepdims=True)
    return (xc * lax.rsqrt(var + EPS) * g.astype(jnp.float32) + b.astype(jnp.float32)).astype(x.dtype)


def modulate(h, shift, scale):
    return h * (1 + scale) + shift


def heads(t):
    return t.reshape(*t.shape[:-1], -1, HEAD_DIM)


def split_proj(p):
    sizes = [A_Q, A_KV, A_KV, 2 * B_CH, C_Q, C_KV, C_KV]
    idx = [int(i) for i in np.cumsum(sizes)[:-1]]
    return jnp.split(p, idx, axis=-1)


def grid_rope(n_tokens):
    rows = n_tokens // GRID_W
    pos_row = jnp.repeat(jnp.arange(rows, dtype=jnp.float32), GRID_W)
    pos_col = jnp.tile(jnp.arange(GRID_W, dtype=jnp.float32), rows)
    n_freq = HEAD_DIM // 4
    inv = ROPE_THETA ** (-jnp.arange(n_freq, dtype=jnp.float32) / n_freq)
    ang = jnp.concatenate([pos_row[:, None] * inv, pos_col[:, None] * inv], axis=-1)
    return jnp.cos(ang), jnp.sin(ang)


def apply_rope(x, cos, sin):
    b, s, h, d = x.shape
    xr = x.reshape(b, s, h, 2, 2, d // 4)
    x1, x2 = xr[..., 0, :], xr[..., 1, :]
    c = cos.reshape(s, 1, 2, d // 4).astype(x.dtype)
    sn = sin.reshape(s, 1, 2, d // 4).astype(x.dtype)
    return jnp.stack([x1 * c - x2 * sn, x2 * c + x1 * sn], axis=-2).reshape(b, s, h, d)


def global_attention(q, k, v, k_ctx, v_ctx):
    b, s, h, d = q.shape
    kv = k.shape[2]
    g = h // kv
    nb = s // BLOCK
    k_all = jnp.concatenate([k, k_ctx], axis=1)
    v_all = jnp.concatenate([v, v_ctx], axis=1)
    qb = q.reshape(b, nb, BLOCK, kv, g, d).transpose(1, 0, 2, 3, 4, 5)

    def one_block(qblk):
        sc = jnp.einsum('bqhgd,bkhd->bhgqk', qblk, k_all).astype(jnp.float32) * ATTN_SCALE
        p = jax.nn.softmax(sc, axis=-1).astype(v_all.dtype)
        return jnp.einsum('bhgqk,bkhd->bqhgd', p, v_all)

    o = lax.map(one_block, qb)
    return o.transpose(1, 0, 2, 3, 4, 5).reshape(b, s, h * d)


def window_attention(q, k, v, k_ctx, v_ctx, sink):
    b, s, h, d = q.shape
    kv = k.shape[2]
    g = h // kv
    nb = s // BLOCK
    lk = k_ctx.shape[1]
    nband = 3 * BLOCK

    def bands(t):
        tp = jnp.pad(t, ((0, 0), (WINDOW, WINDOW), (0, 0), (0, 0)))
        tb = tp.reshape(b, nb + 2, BLOCK, kv, d).transpose(1, 0, 2, 3, 4)
        return jnp.concatenate([tb[:-2], tb[1:-1], tb[2:]], axis=2)

    qpos = jnp.arange(s).reshape(nb, BLOCK)
    kpos = jnp.arange(-WINDOW, s + WINDOW).reshape(nb + 2, BLOCK)
    kpos = jnp.concatenate([kpos[:-2], kpos[1:-1], kpos[2:]], axis=1)
    rel = kpos[:, None, :] - qpos[:, :, None]
    mask = (jnp.abs(rel) <= WINDOW) & (kpos[:, None, :] >= 0) & (kpos[:, None, :] < s)
    qb = q.reshape(b, nb, BLOCK, kv, g, d).transpose(1, 0, 2, 3, 4, 5)
    sink_l = sink.astype(jnp.float32).reshape(kv, g, 1, 1)

    def one_block(args):
        qblk, kblk, vblk, mblk = args
        sl = jnp.einsum('bqhgd,bkhd->bhgqk', qblk, kblk).astype(jnp.float32) * ATTN_SCALE
        sl = jnp.where(mblk, sl, -jnp.inf)
        sc = jnp.einsum('bqhgd,bkhd->bhgqk', qblk, k_ctx).astype(jnp.float32) * ATTN_SCALE
        sk = jnp.broadcast_to(sink_l, sl.shape[:-1] + (1,))
        p = jax.nn.softmax(jnp.concatenate([sl, sc, sk], axis=-1), axis=-1).astype(vblk.dtype)
        return (jnp.einsum('bhgqk,bkhd->bqhgd', p[..., :nband], vblk)
                + jnp.einsum('bhgqk,bkhd->bqhgd', p[..., nband:nband + lk], v_ctx))

    o = lax.map(one_block, (qb, bands(k), bands(v), mask))
    return o.transpose(1, 0, 2, 3, 4, 5).reshape(b, s, h * d)


def context_attention(q, k, v, sink=None):
    b, l, h, d = q.shape
    kv = k.shape[2]
    g = h // kv
    lk = k.shape[1]
    qg = q.reshape(b, l, kv, g, d)
    sc = jnp.einsum('bqhgd,bkhd->bhgqk', qg, k).astype(jnp.float32) * ATTN_SCALE
    if sink is not None:
        sk = jnp.broadcast_to(sink.astype(jnp.float32).reshape(kv, g, 1, 1), sc.shape[:-1] + (1,))
        sc = jnp.concatenate([sc, sk], axis=-1)
    p = jax.nn.softmax(sc, axis=-1)[..., :lk].astype(v.dtype)
    o = jnp.einsum('bhgqk,bkhd->bqhgd', p, v)
    return o.reshape(b, l, h * d)


def conformer_conv(u, conv_w, conv_b, ln_g, ln_b):
    a, gt = jnp.split(u, 2, axis=-1)
    hgl = a * jax.nn.sigmoid(gt)
    hc = lax.conv_general_dilated(hgl, conv_w, window_strides=(1,),
                                  padding=[(CONV_W // 2, CONV_W // 2)],
                                  dimension_numbers=('NWC', 'WIO', 'NWC'),
                                  feature_group_count=B_CH) + conv_b
    return jax.nn.silu(layer_norm(hc, ln_g, ln_b))


def token_mixers(hl, hc, w_in, q_g, k_g, conv_w, conv_b, ln_g, ln_b, sink, cos, sin, with_ctx_out):
    aq, ak, av, bu, cq, ck, cv = split_proj(hl @ w_in)
    aqc, akc, avc, buc, cqc, ckc, cvc = split_proj(hc @ w_in)
    ka_c = rms_norm(heads(akc), k_g)
    va_c = heads(avc)
    qa = apply_rope(rms_norm(heads(aq), q_g), cos, sin)
    ka = apply_rope(rms_norm(heads(ak), k_g), cos, sin)
    out_a = global_attention(qa, ka, heads(av), ka_c, va_c)
    out_b = conformer_conv(bu, conv_w, conv_b, ln_g, ln_b)
    kc_c = heads(ckc)
    vc_c = heads(cvc)
    out_c = window_attention(apply_rope(heads(cq), cos, sin), apply_rope(heads(ck), cos, sin),
                             heads(cv), kc_c, vc_c, sink)
    lat = jnp.concatenate([out_a, out_b, out_c], axis=-1)
    if not with_ctx_out:
        return lat, None
    ctx_a = context_attention(rms_norm(heads(aqc), q_g), ka_c, va_c)
    ctx_b = conformer_conv(buc, conv_w, conv_b, ln_g, ln_b)
    ctx_c = context_attention(heads(cqc), kc_c, vc_c, sink)
    return lat, jnp.concatenate([ctx_a, ctx_b, ctx_c], axis=-1)


def hierarchical_moe(h, w_group, b_group, w_expert, b_expert, w_gate, w_up, w_down):
    t, d = h.shape
    gp = jax.nn.softmax((h @ w_group).astype(jnp.float32) + b_group.astype(jnp.float32), axis=-1)
    g_val, g_idx = lax.top_k(gp, 1)
    el = ((h @ w_expert).astype(jnp.float32) + b_expert.astype(jnp.float32)).reshape(t, N_GROUPS, EXPERTS_PER_GROUP)
    el = jnp.take_along_axis(el, g_idx[:, :, None], axis=1)[:, 0]
    e_val, e_loc = lax.top_k(el, TOP_K)
    e_w = jax.nn.softmax(e_val, axis=-1) * g_val
    e_idx = g_idx * EXPERTS_PER_GROUP + e_loc
    n_assign = t * TOP_K
    flat_e = e_idx.reshape(-1)
    order = jnp.argsort(flat_e)
    sorted_e = flat_e[order]
    tok = order // TOP_K
    counts = jnp.bincount(flat_e, length=N_EXPERTS)
    starts = jnp.cumsum(counts) - counts
    padded = (counts + MOE_CHUNK - 1) // MOE_CHUNK * MOE_CHUNK
    pends = jnp.cumsum(padded)
    pstarts = pends - padded
    dest = pstarts[sorted_e] + (jnp.arange(n_assign) - starts[sorted_e])
    n_chunks = -(-n_assign // MOE_CHUNK) + N_EXPERTS
    buf = jnp.zeros((n_chunks * MOE_CHUNK, d), h.dtype).at[dest].set(h[tok])
    chunk_expert = jnp.clip(jnp.searchsorted(pends, jnp.arange(n_chunks) * MOE_CHUNK, side='right'), 0, N_EXPERTS - 1)

    def run(args):
        xb, e = args
        return (jax.nn.silu(xb @ w_gate[e]) * (xb @ w_up[e])) @ w_down[e]

    out = lax.map(run, (buf.reshape(n_chunks, MOE_CHUNK, d), chunk_expert)).reshape(-1, d)
    w_sorted = e_w.reshape(-1)[order].astype(h.dtype)
    return jnp.zeros_like(h).at[tok].add(out[dest] * w_sorted[:, None])


def setup_inputs(seed: int = 0) -> dict:
    key = jax.random.key(seed)
    ks = jax.random.split(key, 32)
    f32 = jnp.float32

    def nrm(k, shape, scale):
        return jax.random.normal(k, shape, f32) * scale

    D = D_MODEL
    return {
        "x": nrm(ks[0], (BATCH, SEQ, D), 1.0),
        "c": nrm(ks[1], (BATCH, D), 1.0),
        "ctx": nrm(ks[2], (BATCH, CTX_LEN, D), 1.0),
        "c_ctx": nrm(ks[3], (D,), 1.0),
        "norm1_g": 1.0 + nrm(ks[4], (DEPTH, D), 0.05),
        "norm2_g": 1.0 + nrm(ks[5], (DEPTH, D), 0.05),
        "w_mod": nrm(ks[6], (DEPTH, D, N_MOD * D), 0.5 * D ** -0.5),
        "b_mod": nrm(ks[7], (DEPTH, N_MOD * D), 0.02),
        "w_in": nrm(ks[8], (DEPTH, D, D_IN), D ** -0.5),
        "q_norm_g": 1.0 + nrm(ks[9], (DEPTH, HEAD_DIM), 0.05),
        "k_norm_g": 1.0 + nrm(ks[10], (DEPTH, HEAD_DIM), 0.05),
        "conv_w": nrm(ks[11], (DEPTH, CONV_W, 1, B_CH), CONV_W ** -0.5),
        "conv_b": nrm(ks[12], (DEPTH, B_CH), 0.02),
        "conv_ln_g": 1.0 + nrm(ks[13], (DEPTH, B_CH), 0.05),
        "conv_ln_b": nrm(ks[14], (DEPTH, B_CH), 0.02),
        "sink": nrm(ks[15], (DEPTH, C_HEADS), 0.5),
        "w_out": nrm(ks[16], (DEPTH, D_MIX, D), D_MIX ** -0.5),
        "w_group": nrm(ks[17], (DEPTH, D, N_GROUPS), D ** -0.5),
        "b_group": nrm(ks[18], (DEPTH, N_GROUPS), 0.01),
        "w_expert": nrm(ks[19], (DEPTH, D, N_EXPERTS), D ** -0.5),
        "b_expert": nrm(ks[20], (DEPTH, N_EXPERTS), 0.01),
        "w_gate": nrm(ks[21], (DEPTH, N_EXPERTS, D, D_EXPERT), D ** -0.5),
        "w_up": nrm(ks[22], (DEPTH, N_EXPERTS, D, D_EXPERT), D ** -0.5),
        "w_down": nrm(ks[23], (DEPTH, N_EXPERTS, D_EXPERT, D), D_EXPERT ** -0.5),
        "final_g": 1.0 + nrm(ks[24], (D,), 0.05),
    }


def reference(x, c, ctx, c_ctx, norm1_g, norm2_g, w_mod, b_mod, w_in, q_norm_g, k_norm_g,
              conv_w, conv_b, conv_ln_g, conv_ln_b, sink, w_out, w_group, b_group,
              w_expert, b_expert, w_gate, w_up, w_down, final_g):
    b, s, d = x.shape
    cos, sin = grid_rope(s)
    xc = ctx
    for i in range(DEPTH):
        with_ctx_out = i < DEPTH - 1
        sh1, sc1, g1, sh2, sc2, g2 = [m[:, None, :] for m in
                                      jnp.split(jax.nn.silu(c) @ w_mod[i] + b_mod[i], N_MOD, axis=-1)]
        csh1, csc1, cg1, csh2, csc2, cg2 = jnp.split(jax.nn.silu(c_ctx) @ w_mod[i] + b_mod[i], N_MOD, axis=-1)
        hl = modulate(rms_norm(x, norm1_g[i]), sh1, sc1)
        hc = modulate(rms_norm(xc, norm1_g[i]), csh1, csc1)
        lat_mix, ctx_mix = token_mixers(hl, hc, w_in[i], q_norm_g[i], k_norm_g[i], conv_w[i], conv_b[i],
                                        conv_ln_g[i], conv_ln_b[i], sink[i], cos, sin, with_ctx_out)
        x = x + g1 * (lat_mix @ w_out[i])
        moe_w = (w_group[i], b_group[i], w_expert[i], b_expert[i], w_gate[i], w_up[i], w_down[i])
        hl = modulate(rms_norm(x, norm2_g[i]), sh2, sc2).reshape(-1, d)
        if with_ctx_out:
            xc = xc + cg1 * (ctx_mix @ w_out[i])
            hc = modulate(rms_norm(xc, norm2_g[i]), csh2, csc2).reshape(-1, d)
            y = hierarchical_moe(jnp.concatenate([hl, hc], axis=0), *moe_w)
            n_lat = hl.shape[0]
            x = x + g2 * y[:n_lat].reshape(x.shape)
            xc = xc + cg2 * y[n_lat:].reshape(xc.shape)
        else:
            x = x + g2 * hierarchical_moe(hl, *moe_w).reshape(x.shape)
    return rms_norm(x, final_g)
```

```cpp
#include <hip/hip_runtime.h>
#include <cstdint>
#include <cstdio>

#ifndef MK_ONE_LAUNCH
#define MK_ONE_LAUNCH 0
#endif

#define LAS __attribute__((address_space(3)))
#define GAS __attribute__((address_space(1)))
typedef unsigned short bf16_t;
typedef short bf16x8 __attribute__((ext_vector_type(8)));
typedef short s16x4 __attribute__((ext_vector_type(4)));
typedef float f32x4 __attribute__((ext_vector_type(4)));
typedef float f32x2 __attribute__((ext_vector_type(2)));
typedef float f32x16 __attribute__((ext_vector_type(16)));
typedef unsigned u32x4 __attribute__((ext_vector_type(4)));
typedef unsigned u32x2 __attribute__((ext_vector_type(2)));

constexpr int D = 1024, BATCH = 32, SEQ = 2048, DEPTH = 4, CTXL = 256, HD = 64;
constexpr int NLAT = BATCH * SEQ, NCTX = BATCH * CTXL, MT = NLAT + NCTX;
constexpr int DIN = 1792, DMIX = 1024, NMOD = 6;
constexpr int C_AQ = 0, C_AK = 384, C_AV = 512, C_BU = 640, C_BG = 896, C_CQ = 1152, C_CK = 1536, C_CV = 1664;
constexpr int O_A = 0, O_B = 384, O_C = 640;
constexpr int NE = 32, DE = 512, CONVW = 31, BCH = 256;
constexpr int TOKCAP = MT;
constexpr int NP_MAX = (2 * MT / 256 + NE) * 256;
constexpr float EPS = 1e-6f;
constexpr float LOG2E = 1.4426950408889634f;
constexpr float QSCALE = 0.125f * LOG2E;

constexpr size_t MiB = 1u << 20;
constexpr size_t WS_CTL = 0, CTL_ZERO_BYTES = 1 * MiB;
constexpr size_t WS_ROPE = 1 * MiB;
constexpr size_t WS_MOD = 2 * MiB;
constexpr size_t WS_WIN = 6 * MiB;
constexpr size_t WS_WOUT = 20 * MiB;
constexpr size_t WS_WGU = 28 * MiB;
constexpr size_t WS_WD = 284 * MiB;
constexpr size_t WS_XC = 412 * MiB;
constexpr size_t WS_H = 444 * MiB;
constexpr size_t WS_PROJ = 588 * MiB;
constexpr size_t WS_ACT = 892 * MiB;
constexpr size_t WS_TOK = 1044 * MiB;
constexpr size_t WS_SLOT = 1053 * MiB;
constexpr size_t WS_END = 1055 * MiB;
constexpr int CW_BAR = 4096;
constexpr int CW_CNT = 16384;

constexpr int LDS_BYTES = 155648;
constexpr int LDS_REC = 147456;
constexpr int LDS_MISC = 154624;

__device__ __forceinline__ float bf2f(unsigned b) { return __uint_as_float(b << 16); }
__device__ __forceinline__ unsigned f2bf(float f) { unsigned u = __float_as_uint(f); return (u + 0x7fffu + ((u >> 16) & 1u)) >> 16; }
__device__ __forceinline__ unsigned pk2(float lo, float hi) { return f2bf(lo) | (f2bf(hi) << 16); }
__device__ __forceinline__ float wave_sum(float v) {
#pragma unroll
    for (int o = 32; o >= 1; o >>= 1) v += __shfl_xor(v, o);
    return v;
}
#define LDS_WAIT() asm volatile("s_waitcnt lgkmcnt(0)" ::: "memory")
#define VM_WAIT() asm volatile("s_waitcnt vmcnt(0)" ::: "memory")

namespace pg8 {
constexpr int BM = 256, BK = 64, HALF = 128, HTB = HALF * BK * 2, STAGE_BYTES = 8 * HTB, NXCD = 8, WGM = 8;
__host__ __device__ __forceinline__ int lds_byte(int r, int c) { const int st = (r >> 4) * 2 + (c >> 5), rr = r & 15, cc = c & 31, ob = rr * 64 + cc * 2; return st * 1024 + (ob ^ (((ob >> 9) & 1) << 5)); }
__host__ __device__ __forceinline__ void stage_rc(int b, int& R, int& C) { const int st = b / 1024, sb = b % 1024, swz = sb ^ (((sb >> 9) & 1) << 5); R = (st >> 1) * 16 + swz / 64; C = (st & 1) * 32 + (swz % 64) / 2; }
__host__ __device__ __forceinline__ int perm32(int rho) { const int n = rho >> 4, i = rho & 15; return 8 * (i >> 2) + 4 * n + (i & 3); }

struct Unit { int pm, pn, e; };

struct DenseOrder {
    const bf16_t* A; const bf16_t* Bt; int K; int nM, nN, nwg, G, c;
    __device__ void init(const bf16_t* A_, const bf16_t* Bt_, int M, int N, int K_, int G_, int c_) { A = A_; Bt = Bt_; K = K_; nM = M / BM; nN = N / BM; nwg = nM * nN; G = G_; c = c_; }
    __device__ __forceinline__ bool next(int i, Unit& u) const {
        const long L = (long)i * G + c; if (L >= nwg) return false;
        int wgid = (int)L; { const int q = nwg / NXCD, r = nwg % NXCD, xcd = wgid % NXCD, off = wgid / NXCD; wgid = (xcd < r ? xcd * (q + 1) : r * (q + 1) + (xcd - r) * q) + off; }
        const int nig = WGM * nN, gid = wgid / nig, fm = gid * WGM, gsz = (nM - fm) < WGM ? (nM - fm) : WGM;
        u.pm = fm + ((wgid % nig) % gsz); u.pn = (wgid % nig) / gsz; u.e = 0; return true;
    }
    __device__ __forceinline__ const char* a_base(const Unit& u) const { return (const char*)A + (size_t)u.pm * BM * K * 2; }
    __device__ __forceinline__ const char* b_base(const Unit& u) const { return (const char*)Bt + (size_t)u.pn * BM * K * 2; }
    __device__ __forceinline__ unsigned row_off(const Unit&, int) const { return 0u; }
};
struct MoeOrder {
    const bf16_t* A; const bf16_t* W; size_t wstride; int K; int ncol; const LAS int* tstart; int G, c;
    const int* tok; const int* cnt;
    __device__ __forceinline__ bool next(int i, Unit& u) const {
        const long L = (long)i * G + c; const int nt = tstart[NE];
        if (L >= (long)nt * ncol) return false;
        u.pm = (int)(L / ncol); u.pn = (int)(L % ncol);
        int e = 0;
#pragma unroll 1
        for (; e < NE - 1; ++e) if (tstart[e + 1] > u.pm) break;
        u.e = e; return true;
    }
    __device__ __forceinline__ const char* a_base(const Unit& u) const { return (const char*)A + (tok ? (size_t)0 : (size_t)u.pm * BM * K * 2); }
    __device__ __forceinline__ const char* b_base(const Unit& u) const { return (const char*)W + ((size_t)u.e * wstride + (size_t)u.pn * BM * K) * 2; }
    __device__ __forceinline__ unsigned row_off(const Unit& u, int r) const {
        const int n = cnt[u.e]; int p = (u.pm - tstart[u.e]) * BM + r; p = p < n ? p : n - 1;
        return (unsigned)tok[(size_t)u.e * TOKCAP + p] * (unsigned)(K * 2);
    }
};

__device__ __forceinline__ unsigned cvt_pk_bf16(float lo, float hi) { unsigned r; asm volatile("v_cvt_pk_bf16_f32 %0, %1, %2" : "=v"(r) : "v"(lo), "v"(hi)); return r; }

struct EpiBf16 {
    static constexpr bool PERM = true;
    bf16_t* O; int ldc;
    __device__ __forceinline__ void operator()(const f32x4 (&acc)[2][2][4][2], const Unit& u, int wr, int wc, int fr, int fq) const {
        const int row0 = u.pm * BM + wr * 64 + fr, col0 = u.pn * BM + wc * 32 + 8 * fq;
#pragma unroll
        for (int ai = 0; ai < 2; ++ai)
#pragma unroll
            for (int m = 0; m < 4; ++m) { bf16_t* rowp = O + (size_t)(row0 + ai * HALF + m * 16) * ldc + col0;
#pragma unroll
                for (int bj = 0; bj < 2; ++bj) { const f32x4 v0 = acc[ai][bj][m][0], v1 = acc[ai][bj][m][1];
                    u32x4 w; w.x = cvt_pk_bf16(v0[0], v0[1]); w.y = cvt_pk_bf16(v0[2], v0[3]); w.z = cvt_pk_bf16(v1[0], v1[1]); w.w = cvt_pk_bf16(v1[2], v1[3]);
                    *(u32x4*)(rowp + bj * HALF) = w; } }
    }
};
struct EpiGlu {
    static constexpr bool PERM = true;
    bf16_t* O;
    __device__ __forceinline__ void operator()(const f32x4 (&acc)[2][2][4][2], const Unit& u, int wr, int wc, int fr, int fq) const {
        const int row0 = u.pm * BM + wr * 64 + fr, col0 = u.pn * HALF + wc * 32 + 8 * fq;
#pragma unroll
        for (int ai = 0; ai < 2; ++ai)
#pragma unroll
            for (int m = 0; m < 4; ++m) { bf16_t* rowp = O + (size_t)(row0 + ai * HALF + m * 16) * DE + col0;
                float r[8];
#pragma unroll
                for (int n = 0; n < 2; ++n)
#pragma unroll
                    for (int i = 0; i < 4; ++i) { const float g = acc[ai][0][m][n][i], up = acc[ai][1][m][n][i];
                        r[n * 4 + i] = g * __builtin_amdgcn_rcpf(1.0f + __builtin_amdgcn_exp2f(-g * LOG2E)) * up; }
                u32x4 w; w.x = cvt_pk_bf16(r[0], r[1]); w.y = cvt_pk_bf16(r[2], r[3]); w.z = cvt_pk_bf16(r[4], r[5]); w.w = cvt_pk_bf16(r[6], r[7]);
                *(u32x4*)rowp = w; }
    }
};
struct EpiResid {
    static constexpr bool PERM = false;
    const float* xin_lat; const float* xin_ctx; float* xout_lat; float* xout_ctx; const float* gate;
    __device__ __forceinline__ void operator()(const f32x4 (&acc)[2][2][4][2], const Unit& u, int wr, int wc, int fr, int fq) const {
        const int col0 = u.pn * BM + wc * 32 + 4 * fq;
        const bool lat = u.pm < NLAT / BM;
        const int mrow = lat ? (u.pm >> 3) : BATCH;
        const size_t rbase = lat ? (size_t)u.pm * BM : (size_t)u.pm * BM - NLAT;
        const float* xin = lat ? xin_lat : xin_ctx; float* xout = lat ? xout_lat : xout_ctx;
        f32x4 gv[2][2];
#pragma unroll
        for (int bj = 0; bj < 2; ++bj)
#pragma unroll
            for (int n = 0; n < 2; ++n) gv[bj][n] = *(const f32x4*)(gate + (size_t)mrow * (NMOD * D) + col0 + bj * HALF + n * 16);
#pragma unroll
        for (int ai = 0; ai < 2; ++ai)
#pragma unroll
            for (int m = 0; m < 4; ++m) { const size_t off = (rbase + ai * HALF + wr * 64 + m * 16 + fr) * D + col0;
#pragma unroll
                for (int bj = 0; bj < 2; ++bj)
#pragma unroll
                    for (int n = 0; n < 2; ++n) { const f32x4 xi = *(const f32x4*)(xin + off + bj * HALF + n * 16);
                        *(f32x4*)(xout + off + bj * HALF + n * 16) = xi + gv[bj][n] * acc[ai][bj][m][n]; } }
    }
};

template <class Epi, class Sched, bool GATHER, bool ALIGN_EPI>
__device__ __forceinline__ void gemm_phase(LAS unsigned char* lds, const int K, const Sched& S, const Epi& E) {
    int tid = threadIdx.x; asm volatile("" : "+v"(tid));
    const int wid = __builtin_amdgcn_readfirstlane(tid >> 6), lane = tid & 63, wr = wid >> 2, wc = wid & 3, fr = lane & 15, fq = lane >> 4;
    const int nt = K / BK;
    unsigned voffA[2], voffB[2]; int sR[2], sC2[2];
#pragma unroll
    for (int i = 0; i < 2; ++i) { int R, C; stage_rc(tid * 16 + i * 8192, R, C); const int Rb = Epi::PERM ? ((R & ~31) + perm32(R & 31)) : R;
        voffA[i] = (unsigned)(R * K + C) * 2u; voffB[i] = (unsigned)(Rb * K + C) * 2u; sR[i] = R; sC2[i] = C * 2; }
    const size_t kstep = (size_t)(BK * 2);
    const size_t hstep = (size_t)HALF * K * 2;
    const unsigned ldsw = (unsigned)wid * 1024u;
    const int aoff = lds_byte(wr * 64 + fr, fq * 8), boff = lds_byte(wc * 32 + fr, fq * 8);
#define PG8_SA(b, h) (((b) * 2 + (h)) * HTB)
#define PG8_SB(b, h) ((4 + (b) * 2 + (h)) * HTB)
#define PG8_STAGE(bufoff, gbase, voff) do { _Pragma("unroll") for (int _i = 0; _i < 2; ++_i) \
        __builtin_amdgcn_global_load_lds((const unsigned*)((const char*)(gbase) + (voff)[_i]), (LAS unsigned*)(lds + (bufoff) + ldsw + _i * 8192), 16, 0, 0); } while (0)
#define PG8_STAGE_A(bufoff, kp, h, O0, O1) do { if constexpr (GATHER) { if ((h) == 0) PG8_STAGE(bufoff, kp, O0); else PG8_STAGE(bufoff, kp, O1); } else { PG8_STAGE(bufoff, (kp) + (h) * hstep, voffA); } } while (0)
#define PG8_LDA(dst, b, h) do { _Pragma("unroll") for (int m = 0; m < 4; ++m) _Pragma("unroll") for (int k = 0; k < 2; ++k) dst[m][k] = *(const LAS bf16x8*)(lds + PG8_SA(b, h) + aoff + m * 2048 + k * 1024); } while (0)
#define PG8_LDB(dst, b, h) do { _Pragma("unroll") for (int n = 0; n < 2; ++n) _Pragma("unroll") for (int k = 0; k < 2; ++k) dst[n][k] = *(const LAS bf16x8*)(lds + PG8_SB(b, h) + boff + n * 2048 + k * 1024); } while (0)
#define PG8_MMA(ai, bj, At, Bt) do { __builtin_amdgcn_s_setprio(1); _Pragma("unroll") for (int m = 0; m < 4; ++m) _Pragma("unroll") for (int n = 0; n < 2; ++n) _Pragma("unroll") for (int k = 0; k < 2; ++k) \
        acc[ai][bj][m][n] = __builtin_amdgcn_mfma_f32_16x16x32_bf16(Bt[n][k], At[m][k], acc[ai][bj][m][n], 0, 0, 0); __builtin_amdgcn_s_setprio(0); } while (0)
#define PG8_WAIT_V(n) asm volatile("s_waitcnt vmcnt(" #n ")" ::: "memory")
#define PG8_WAIT_L(n) asm volatile("s_waitcnt lgkmcnt(" #n ")" ::: "memory")
#define PG8_BAR __builtin_amdgcn_s_barrier()
#define PG8_SCHED __builtin_amdgcn_sched_barrier(0)
    Unit cur, nxt; int ui = 0;
    if (!S.next(0, cur)) return;
    f32x4 acc[2][2][4][2];
#pragma unroll
    for (int a = 0; a < 2; ++a)
#pragma unroll
        for (int b = 0; b < 2; ++b)
#pragma unroll
            for (int m = 0; m < 4; ++m)
#pragma unroll
                for (int n = 0; n < 2; ++n) acc[a][b][m][n] = (f32x4){0.f, 0.f, 0.f, 0.f};
    bf16x8 At[4][2], B0[2][2], B1[2][2];
    const char* cA = S.a_base(cur); const char* cB = S.b_base(cur);
    unsigned ca0[2] = {0u, 0u}, ca1[2] = {0u, 0u}, na0[2] = {0u, 0u}, na1[2] = {0u, 0u};
    if constexpr (GATHER) {
#pragma unroll
        for (int i = 0; i < 2; ++i) { ca0[i] = S.row_off(cur, sR[i]) + (unsigned)sC2[i]; ca1[i] = S.row_off(cur, HALF + sR[i]) + (unsigned)sC2[i]; }
    }
    PG8_STAGE(PG8_SB(0, 0), cB, voffB); PG8_STAGE(PG8_SB(0, 1), cB + hstep, voffB); PG8_STAGE_A(PG8_SA(0, 0), cA, 0, ca0, ca1); PG8_STAGE_A(PG8_SA(0, 1), cA, 1, ca0, ca1);
    if (wr == 1) PG8_BAR;
    PG8_WAIT_V(2); PG8_BAR;
    PG8_STAGE(PG8_SB(1, 0), cB + kstep, voffB); PG8_STAGE_A(PG8_SA(1, 0), cA + kstep, 0, ca0, ca1); PG8_STAGE(PG8_SB(1, 1), cB + hstep + kstep, voffB);
    PG8_WAIT_V(6); PG8_BAR;
    for (;;) {
        const bool has_next = S.next(ui + 1, nxt);
        const char* nA = has_next ? S.a_base(nxt) : cA; const char* nB = has_next ? S.b_base(nxt) : cB;
        if constexpr (GATHER) {
            if (has_next) {
#pragma unroll
                for (int i = 0; i < 2; ++i) { na0[i] = S.row_off(nxt, sR[i]) + (unsigned)sC2[i]; na1[i] = S.row_off(nxt, HALF + sR[i]) + (unsigned)sC2[i]; }
            } else { na0[0] = ca0[0]; na0[1] = ca0[1]; na1[0] = ca1[0]; na1[1] = ca1[1]; }
        }
        for (int t = 0; t < nt; t += 2) {
            const bool last = (t == nt - 2);
            const char* a1 = cA + (size_t)(t + 1) * kstep;
            const char* a2 = last ? nA : cA + (size_t)(t + 2) * kstep; const char* b2 = last ? nB : cB + (size_t)(t + 2) * kstep;
            const char* a3 = a2 + kstep; const char* b3 = b2 + kstep;
            unsigned x0[2], x1[2];
            x0[0] = last ? na0[0] : ca0[0]; x0[1] = last ? na0[1] : ca0[1]; x1[0] = last ? na1[0] : ca1[0]; x1[1] = last ? na1[1] : ca1[1];
            PG8_LDB(B0, 0, 0); PG8_LDB(B1, 0, 1); PG8_SCHED; PG8_LDA(At, 0, 0); PG8_STAGE_A(PG8_SA(1, 1), a1, 1, ca0, ca1);
            PG8_WAIT_V(8); PG8_WAIT_L(0); PG8_BAR; PG8_MMA(0, 0, At, B0); PG8_MMA(0, 1, At, B1); PG8_BAR; PG8_SCHED;
            PG8_LDA(At, 0, 1); PG8_STAGE(PG8_SB(0, 0), b2, voffB); PG8_STAGE(PG8_SB(0, 1), b2 + hstep, voffB); PG8_STAGE_A(PG8_SA(0, 0), a2, 0, x0, x1);
            PG8_WAIT_V(8); PG8_WAIT_L(0); PG8_BAR; PG8_MMA(1, 0, At, B0); PG8_MMA(1, 1, At, B1); PG8_BAR; PG8_SCHED;
            PG8_LDB(B0, 1, 0); PG8_LDB(B1, 1, 1); PG8_SCHED; PG8_LDA(At, 1, 0); PG8_STAGE_A(PG8_SA(0, 1), a2, 1, x0, x1);
            PG8_WAIT_V(8); PG8_WAIT_L(0); PG8_BAR; PG8_MMA(0, 0, At, B0); PG8_MMA(0, 1, At, B1); PG8_BAR; PG8_SCHED;
            PG8_LDA(At, 1, 1); PG8_STAGE(PG8_SB(1, 0), b3, voffB); PG8_STAGE(PG8_SB(1, 1), b3 + hstep, voffB); PG8_STAGE_A(PG8_SA(1, 0), a3, 0, x0, x1);
            PG8_WAIT_V(8); PG8_WAIT_L(0); PG8_BAR; PG8_MMA(1, 0, At, B0); PG8_MMA(1, 1, At, B1); PG8_BAR; PG8_SCHED;
        }
        if constexpr (ALIGN_EPI) { if (wr == 0) PG8_BAR; }
        E(acc, cur, wr, wc, fr, fq);
        if (!has_next) break;
#pragma unroll
        for (int a = 0; a < 2; ++a)
#pragma unroll
            for (int b = 0; b < 2; ++b)
#pragma unroll
                for (int m = 0; m < 4; ++m)
#pragma unroll
                    for (int n = 0; n < 2; ++n) acc[a][b][m][n] = (f32x4){0.f, 0.f, 0.f, 0.f};
        cur = nxt; cA = nA; cB = nB; ++ui;
        if constexpr (GATHER) { ca0[0] = na0[0]; ca0[1] = na0[1]; ca1[0] = na1[0]; ca1[1] = na1[1]; }
        if constexpr (ALIGN_EPI) { if (wr == 1) PG8_BAR; }
    }
    PG8_WAIT_V(0);
    if constexpr (!ALIGN_EPI) { if (wr == 0) PG8_BAR; }
    PG8_BAR;
#undef PG8_SA
#undef PG8_SB
#undef PG8_STAGE
#undef PG8_STAGE_A
#undef PG8_LDA
#undef PG8_LDB
#undef PG8_MMA
#undef PG8_WAIT_V
#undef PG8_WAIT_L
#undef PG8_BAR
#undef PG8_SCHED
}
}

#define XB_TMO      128
#define XB_XCNT(j)  (256  + 64 * (j))
#define XB_XSUB(j)  (1280 + 64 * (j))
#define XB_XGEN(j)  (2304 + 64 * (j))
#define XB_TOP      3328
#define XB_TOPGEN   3392
#define XCD_BAR_WORDS 3456
#define XB_SPIN_CAP (1u << 22)
__device__ __forceinline__ unsigned xb_ld(unsigned* p)              { return __hip_atomic_load(p, __ATOMIC_RELAXED, __HIP_MEMORY_SCOPE_AGENT); }
__device__ __forceinline__ unsigned xb_add(unsigned* p, unsigned v) { return __hip_atomic_fetch_add(p, v, __ATOMIC_RELAXED, __HIP_MEMORY_SCOPE_AGENT); }
__device__ __forceinline__ unsigned xb_xcc_id() { return (unsigned)__builtin_amdgcn_s_getreg((3 << 11) | 20) & 0xFu; }
#define XB_SPIN(cond, bar) do { unsigned _sp = 0; while (cond) { __builtin_amdgcn_s_sleep(1); \
    if ((++_sp & 255u) == 0u) { if (xb_ld(&(bar)[XB_TMO])) break; if (_sp > XB_SPIN_CAP) { atomicAdd(&(bar)[XB_TMO], 1u); break; } } } } while (0)
struct XcdBarrier { unsigned* bar; unsigned x; volatile LAS unsigned* st; };
__device__ __forceinline__ XcdBarrier xcd_barrier_post(unsigned* bar, volatile LAS unsigned* st) {
    XcdBarrier b; b.bar = bar; b.x = xb_xcc_id(); b.st = st;
    if (threadIdx.x == 0) (void)xb_add(&bar[XB_XCNT(b.x)], 1u);
    return b;
}
__device__ __forceinline__ void xcd_barrier_complete(unsigned* bar, unsigned x, unsigned& nloc, unsigned& nx) {
    const unsigned G = gridDim.x * gridDim.y * gridDim.z;
    unsigned sum, cnt, mine, sp = 0u;
    for (;;) {
        sum = 0u; cnt = 0u; mine = 0u;
#pragma unroll
        for (unsigned j = 0; j < 16; ++j) { const unsigned c = xb_ld(&bar[XB_XCNT(j)]); sum += c; cnt += (c > 0u) ? 1u : 0u; mine = (j == x) ? c : mine; }
        if (sum == G) break;
        __builtin_amdgcn_s_sleep(1);
        if ((++sp & 255u) == 0u) { if (xb_ld(&bar[XB_TMO])) break; if (sp > XB_SPIN_CAP) { atomicAdd(&bar[XB_TMO], 1u); break; } }
    }
    nloc = mine > 0u ? mine : 1u; nx = cnt > 0u ? cnt : 1u;
}
__device__ __forceinline__ void xcd_barrier(const XcdBarrier& b) {
    asm volatile("s_waitcnt vmcnt(0)" ::: "memory");
    __syncthreads();
    if (threadIdx.x == 0) {
        unsigned* bar = b.bar;
        __builtin_amdgcn_s_waitcnt(0);
        unsigned nloc = b.st[0], nx = b.st[1];
        if (nloc == 0u) { xcd_barrier_complete(bar, b.x, nloc, nx); b.st[0] = nloc; b.st[1] = nx; }
        const unsigned old = xb_add(&bar[XB_XSUB(b.x)], 1u);
        const unsigned gen = old / nloc;
        if (old + 1u == (gen + 1u) * nloc) {
            __builtin_amdgcn_fence(__ATOMIC_RELEASE, "agent");
            asm volatile("s_waitcnt vmcnt(0)" ::: "memory");
            const unsigned og = xb_add(&bar[XB_TOP], 1u);
            const unsigned tg = og / nx;
            if (og + 1u == (tg + 1u) * nx) xb_add(&bar[XB_TOPGEN], 1u);
            else XB_SPIN(xb_ld(&bar[XB_TOPGEN]) == tg, bar);
            __builtin_amdgcn_fence(__ATOMIC_ACQUIRE, "agent");
            xb_add(&bar[XB_XGEN(b.x)], 1u);
            asm volatile("s_waitcnt vmcnt(0)" ::: "memory");
        } else {
            XB_SPIN(xb_ld(&bar[XB_XGEN(b.x)]) == gen, bar);
            __builtin_amdgcn_fence(__ATOMIC_ACQUIRE, "agent");
            asm volatile("s_waitcnt vmcnt(0)" ::: "memory");
        }
    }
    __syncthreads();
}

enum { I_X = 0, I_C, I_CTX, I_CCTX, I_N1G, I_N2G, I_WMOD, I_BMOD, I_WIN, I_QG, I_KG, I_CONVW, I_CONVB, I_LNG, I_LNB, I_SINK, I_WOUT, I_WGRP, I_BGRP, I_WEXP, I_BEXP, I_WGATE, I_WUP, I_WDOWN, I_FING, N_IN };
struct Args { const float* in[N_IN]; float* out; unsigned char* ws; int ph_lo, ph_hi; };
struct Frame {
    LAS unsigned char* lds;
    int tid, lane, wave, G, vcu;
    const float* const* in; float* out; unsigned char* ws;
};
__device__ __forceinline__ void frame_ids(Frame& F) { int t = threadIdx.x; asm volatile("" : "+v"(t)); F.tid = t; F.lane = t & 63; F.wave = __builtin_amdgcn_readfirstlane(t >> 6); }
constexpr int NPH_LAYER = 8, PH_FINAL = 1 + NPH_LAYER * DEPTH, NPHASES = PH_FINAL + 1;

__device__ __forceinline__ void transpose_item(const float* W, int K, int N, int k0, int n0, bf16_t* dst_rows, LAS float* scr, int lane) {
#pragma unroll 8
    for (int i = 0; i < 32; ++i) { const int kk = 2 * i + (lane >> 5); scr[kk * 33 + (lane & 31)] = W[(size_t)(k0 + kk) * N + n0 + (lane & 31)]; }
    LDS_WAIT();
    const int c = lane & 7;
#pragma unroll
    for (int j = 0; j < 4; ++j) { const int n = (lane >> 3) + 8 * j; const LAS float* s = scr + (8 * c) * 33 + n;
        u32x4 o; o.x = pk2(s[0 * 33], s[1 * 33]); o.y = pk2(s[2 * 33], s[3 * 33]); o.z = pk2(s[4 * 33], s[5 * 33]); o.w = pk2(s[6 * 33], s[7 * 33]);
        *(u32x4*)(dst_rows + (size_t)n * K + k0 + 8 * c) = o; }
    LDS_WAIT();
}
__device__ __forceinline__ void p0_prologue(Frame& F) {
    frame_ids(F);
    LAS float* scr = (LAS float*)(F.lds + F.wave * 16384);
    const int gw = F.vcu * 8 + F.wave, NGW = F.G * 8;
    bf16_t* Win_t = (bf16_t*)(F.ws + WS_WIN); bf16_t* Wout_t = (bf16_t*)(F.ws + WS_WOUT); bf16_t* Wgu_t = (bf16_t*)(F.ws + WS_WGU); bf16_t* Wd_t = (bf16_t*)(F.ws + WS_WD);
    constexpr int T_IN = DEPTH * 16 * 56, T_OUT = DEPTH * 16 * 32, T_G = DEPTH * NE * 16 * 16, T_D = DEPTH * NE * 8 * 32;
    constexpr int NITEMS = T_IN + T_OUT + 2 * T_G + T_D;
    for (int it = gw; it < NITEMS; it += NGW) {
        int r = it;
        if (r < T_IN) { const int l = r / 896, q = r % 896, kb = q / 56, nb = q % 56;
            transpose_item(F.in[I_WIN] + (size_t)l * D * DIN, D, DIN, 64 * kb, 32 * nb, Win_t + ((size_t)l * DIN + 32 * nb) * D, scr, F.lane); continue; }
        r -= T_IN;
        if (r < T_OUT) { const int l = r / 512, q = r % 512, kb = q / 32, nb = q % 32;
            transpose_item(F.in[I_WOUT] + (size_t)l * DMIX * D, DMIX, D, 64 * kb, 32 * nb, Wout_t + ((size_t)l * D + 32 * nb) * DMIX, scr, F.lane); continue; }
        r -= T_OUT;
        if (r < 2 * T_G) { const int up = r >= T_G; if (up) r -= T_G; const int mat = r / 256, q = r % 256, kb = q / 16, nb = q % 16, n0 = 32 * nb;
            const int drow = 256 * (n0 / 128) + (n0 % 128) + (up ? 128 : 0);
            transpose_item(F.in[up ? I_WUP : I_WGATE] + (size_t)mat * D * DE, D, DE, 64 * kb, n0, Wgu_t + ((size_t)mat * 1024 + drow) * D, scr, F.lane); continue; }
        r -= 2 * T_G;
        { const int mat = r / 256, q = r % 256, kb = q / 32, nb = q % 32;
            transpose_item(F.in[I_WDOWN] + (size_t)mat * DE * D, DE, D, 64 * kb, 32 * nb, Wd_t + ((size_t)mat * D + 32 * nb) * DE, scr, F.lane); }
    }
    { float* rope = (float*)(F.ws + WS_ROPE); const int gt = F.vcu * 512 + F.tid;
      if (gt < 1024) { const int pos = gt >> 4, f = gt & 15; const float inv = powf(10000.0f, -(float)f / 16.0f); const float ang = (float)pos * inv; rope[gt] = cosf(ang); rope[1024 + gt] = sinf(ang); } }
    __syncthreads();
    { LAS float* sc = (LAS float*)F.lds;
      float* mod = (float*)(F.ws + WS_MOD);
      for (int un = F.vcu; un < DEPTH * 192; un += F.G) {
          const int l = un / 192, n0 = (un % 192) * 32;
          for (int idx = F.tid; idx < 33 * 1024; idx += 512) { const int r = idx >> 10, k = idx & 1023; const float v = r < 32 ? F.in[I_C][r * 1024 + k] : F.in[I_CCTX][k]; sc[idx] = v / (1.0f + __expf(-v)); }
          __syncthreads();
          const int col = F.tid & 31, kg = F.tid >> 5;
          float acc[33];
#pragma unroll
          for (int r = 0; r < 33; ++r) acc[r] = 0.f;
          const float* wp = F.in[I_WMOD] + ((size_t)l * D + kg * 64) * (NMOD * D) + n0 + col;
          for (int k = 0; k < 64; ++k) { const float w = wp[(size_t)k * (NMOD * D)];
#pragma unroll
              for (int r = 0; r < 33; ++r) acc[r] += sc[r * 1024 + kg * 64 + k] * w; }
#pragma unroll
          for (int r = 0; r < 33; ++r) acc[r] += __shfl_xor(acc[r], 32);
          __syncthreads();
          LAS float* red = (LAS float*)F.lds;
          if (F.lane < 32) {
#pragma unroll
              for (int r = 0; r < 33; ++r) red[(F.wave * 33 + r) * 32 + col] = acc[r]; }
          __syncthreads();
          for (int idx = F.tid; idx < 33 * 32; idx += 512) { const int r = idx >> 5, cc = idx & 31; float s = 0.f;
#pragma unroll
              for (int w = 0; w < 8; ++w) s += red[(w * 33 + r) * 32 + cc];
              mod[((size_t)l * 33 + r) * (NMOD * D) + n0 + cc] = s + F.in[I_BMOD][l * (NMOD * D) + n0 + cc]; }
          __syncthreads();
      }
    }
}

__device__ __forceinline__ void build_tstart(Frame& F, int layer) {
    frame_ids(F);
    LAS int* ts = (LAS int*)(F.lds + LDS_MISC) + 16;
    if (F.tid == 0) { const unsigned* cnt = (const unsigned*)(F.ws + WS_CTL) + CW_CNT + layer * NE; int s = 0;
        for (int e = 0; e < NE; ++e) { ts[e] = s; s += ((int)cnt[e] + 255) >> 8; } ts[NE] = s; }
    __syncthreads();
}
template <int MODE>
__device__ __forceinline__ void p_norm(Frame& F, int layer, int comb_layer, int nrows) {
    frame_ids(F);
    const int gw = F.vcu * 8 + F.wave, NGW = F.G * 8;
    const float* mod = (const float*)(F.ws + WS_MOD);
    const bf16_t* Y = (const bf16_t*)(F.ws + WS_PROJ);
    const u32x4* slot = (const u32x4*)(F.ws + WS_SLOT);
    bf16_t* H = (bf16_t*)(F.ws + WS_H);
    const LAS int* ts = (const LAS int*)(F.lds + LDS_MISC) + 16;
    if (comb_layer >= 0) build_tstart(F, comb_layer);
    const float* gptr = MODE == 0 ? F.in[I_N1G] + layer * D : F.in[I_FING];
    f32x4 g[4];
#pragma unroll
    for (int j = 0; j < 4; ++j) g[j] = *(const f32x4*)(gptr + 4 * F.lane + 256 * j);
    for (int r = gw; r < nrows; r += NGW) {
        const bool lat = r < NLAT; const int mrow = lat ? r / SEQ : BATCH;
        const float* xin; float* xout;
        if (lat) { xout = F.out + (size_t)r * D; xin = (layer == 0 && MODE == 0) ? F.in[I_X] + (size_t)r * D : xout; }
        else { xout = (float*)(F.ws + WS_XC) + (size_t)(r - NLAT) * D; xin = (layer == 0 && MODE == 0) ? F.in[I_CTX] + (size_t)(r - NLAT) * D : xout; }
        f32x4 v[4];
#pragma unroll
        for (int j = 0; j < 4; ++j) v[j] = *(const f32x4*)(xin + 4 * F.lane + 256 * j);
        if (comb_layer >= 0) {
            const u32x4 si = slot[r];
            const int e0 = si.x >> 20, e1 = si.y >> 20;
            const size_t p0 = (size_t)ts[e0] * 256 + (si.x & 0xfffffu), p1 = (size_t)ts[e1] * 256 + (si.y & 0xfffffu);
            const float w0 = __uint_as_float(si.z), w1 = __uint_as_float(si.w);
            const float* g2 = mod + ((size_t)comb_layer * 33 + mrow) * (NMOD * D) + 5 * D;
#pragma unroll
            for (int j = 0; j < 4; ++j) {
                const u32x2 a = *(const u32x2*)(Y + p0 * D + 4 * F.lane + 256 * j), b = *(const u32x2*)(Y + p1 * D + 4 * F.lane + 256 * j);
                const f32x4 gg = *(const f32x4*)(g2 + 4 * F.lane + 256 * j);
                f32x4 ya = {bf2f(a.x & 0xffffu), bf2f(a.x >> 16), bf2f(a.y & 0xffffu), bf2f(a.y >> 16)};
                f32x4 yb = {bf2f(b.x & 0xffffu), bf2f(b.x >> 16), bf2f(b.y & 0xffffu), bf2f(b.y >> 16)};
                v[j] = v[j] + gg * (ya * w0 + yb * w1);
                if (MODE == 0) *(f32x4*)(xout + 4 * F.lane + 256 * j) = v[j];
            }
        }
        float ss = 0.f;
#pragma unroll
        for (int j = 0; j < 4; ++j) ss += (v[j].x * v[j].x + v[j].y * v[j].y) + (v[j].z * v[j].z + v[j].w * v[j].w);
        const float rstd = 1.0f / sqrtf(wave_sum(ss) * (1.0f / D) + EPS);
        if (MODE == 0) {
            const float* mp = mod + ((size_t)layer * 33 + mrow) * (NMOD * D);
#pragma unroll
            for (int j = 0; j < 4; ++j) { const f32x4 sh = *(const f32x4*)(mp + 4 * F.lane + 256 * j), sc = *(const f32x4*)(mp + D + 4 * F.lane + 256 * j);
                const f32x4 h = (v[j] * rstd * g[j]) * (sc + 1.0f) + sh;
                u32x2 o; o.x = pk2(h.x, h.y); o.y = pk2(h.z, h.w);
                *(u32x2*)(H + (size_t)r * D + 4 * F.lane + 256 * j) = o; }
        } else {
#pragma unroll
            for (int j = 0; j < 4; ++j) *(f32x4*)(xout + 4 * F.lane + 256 * j) = v[j] * rstd * g[j];
        }
    }
}

__device__ __forceinline__ void p3_postproj(Frame& F, int layer) {
    frame_ids(F);
    const int gw = F.vcu * 8 + F.wave, NGW = F.G * 8, l = F.lane;
    bf16_t* P = (bf16_t*)(F.ws + WS_PROJ);
    const float* rope = (const float*)(F.ws + WS_ROPE);
    const float qg = F.in[I_QG][layer * HD + l], kg = F.in[I_KG][layer * HD + l];
    const int f = l & 15, a = l >> 5, t = (l >> 4) & 1;
    for (int r = gw; r < MT; r += NGW) {
        bf16_t* row = P + (size_t)r * DIN;
        const bool lat = r < NLAT; const int s = r & (SEQ - 1);
        const int pos = a == 0 ? (s >> 6) : (s & 63);
        const float cs = rope[pos * 16 + f], sn = rope[1024 + pos * 16 + f];
#pragma unroll
        for (int hh = 0; hh < 16; ++hh) {
            const int col = (hh < 8 ? C_AQ + hh * 64 : (hh < 14 ? C_CQ + (hh - 8) * 64 : C_CK + (hh - 14) * 64)) + l;
            const bool isq = hh < 6 || (hh >= 8 && hh < 14);
            float v = bf2f(row[col]);
            if (hh < 8) { const float ss = wave_sum(v * v); v = v * (1.0f / sqrtf(ss * (1.0f / HD) + EPS)) * (hh < 6 ? qg : kg); }
            if (lat) { const float p = __shfl_xor(v, 16); v = t == 0 ? v * cs - p * sn : v * cs + p * sn; }
            if (isq) v *= QSCALE;
            row[col] = (bf16_t)f2bf(v);
        }
#pragma unroll
        for (int j = 0; j < 4; ++j) { const float av = bf2f(row[C_BU + j * 64 + l]), gv = bf2f(row[C_BG + j * 64 + l]);
            row[C_BU + j * 64 + l] = (bf16_t)f2bf(av / (1.0f + __expf(-gv))); }
    }
}

struct AttnUnit { int qrow0, qpos0, qcol, kcol, vcol, ocol, krow_ctx, krow_band, nband, kpos0, masked, has_sink; float sink2; };
__device__ __forceinline__ int crow(int r, int hi) { return (r & 3) + 8 * (r >> 2) + 4 * hi; }
__device__ __forceinline__ s16x4 vtr(const LAS unsigned char* p) { typedef short v4i16_t __attribute__((ext_vector_type(4))); return __builtin_bit_cast(s16x4, __builtin_amdgcn_ds_read_tr16_b64_v4i16((LAS v4i16_t*)p)); }
constexpr int AT_PITCH = 144, AT_K = 0, AT_V = 64 * AT_PITCH, AT_WS = 2 * 64 * AT_PITCH;
__device__ __forceinline__ void attn_unit_v1(const AttnUnit& u, const bf16_t* proj, bf16_t* mix, LAS unsigned char* lds) {
    int tid = threadIdx.x; asm volatile("" : "+v"(tid));
    const int lane = tid & 63, r32 = lane & 31, hi = lane >> 5; const int wid = __builtin_amdgcn_readfirstlane(tid >> 6);
    LAS unsigned char* Ks = lds + AT_K; LAS unsigned char* Vs = lds + AT_V; LAS float* wsf = (LAS float*)(lds + AT_WS) + wid * 64;
    const bf16_t* qp = proj + (size_t)(u.qrow0 + wid * 32 + r32) * DIN + u.qcol + 8 * hi;
    bf16x8 qf[4];
#pragma unroll
    for (int d0 = 0; d0 < 4; ++d0) qf[d0] = *(const bf16x8*)(qp + 16 * d0);
    float m = -INFINITY, l = 0.f; f32x16 o0 = {}, o1 = {};
    const int srow = tid >> 3, sch = tid & 7;
    const int ntile = 4 + u.nband;
    const int vq = (lane & 15) >> 2, vp = lane & 3, vg = (lane >> 4) & 1;
    const LAS unsigned char* vbase = Vs + (4 * hi + vq) * AT_PITCH + (16 * vg + 4 * vp) * 2;
    for (int t = 0; t < ntile; ++t) {
        const int krow = (t < 4) ? u.krow_ctx + 64 * t : u.krow_band + 64 * (t - 4);
        const bf16_t* src = proj + (size_t)(krow + srow) * DIN + sch * 8;
        const u32x4 kv = *(const u32x4*)(src + u.kcol); const u32x4 vv = *(const u32x4*)(src + u.vcol);
        __syncthreads();
        *(LAS u32x4*)(Ks + srow * AT_PITCH + sch * 16) = kv; *(LAS u32x4*)(Vs + srow * AT_PITCH + sch * 16) = vv;
        __syncthreads();
        f32x16 p0 = {}, p1 = {};
#pragma unroll
        for (int d0 = 0; d0 < 4; ++d0) {
            const bf16x8 a0 = *(const LAS bf16x8*)(Ks + r32 * AT_PITCH + (16 * d0 + 8 * hi) * 2);
            const bf16x8 a1 = *(const LAS bf16x8*)(Ks + (32 + r32) * AT_PITCH + (16 * d0 + 8 * hi) * 2);
            p0 = __builtin_amdgcn_mfma_f32_32x32x16_bf16(a0, qf[d0], p0, 0, 0, 0);
            p1 = __builtin_amdgcn_mfma_f32_32x32x16_bf16(a1, qf[d0], p1, 0, 0, 0);
        }
        if (u.masked && t >= 4) {
            const int qpos = u.qpos0 + wid * 32 + r32, kb = u.kpos0 + 64 * (t - 4) + 4 * hi;
#pragma unroll
            for (int r = 0; r < 16; ++r) { const int dd = kb + (r & 3) + 8 * (r >> 2) - qpos;
                if (dd > 128 || dd < -128) p0[r] = -INFINITY;
                if (dd + 32 > 128 || dd + 32 < -128) p1[r] = -INFINITY; }
        }
        float mx = fmaxf(p0[0], p1[0]);
#pragma unroll
        for (int r = 1; r < 16; ++r) mx = fmaxf(mx, fmaxf(p0[r], p1[r]));
        mx = fmaxf(mx, __shfl_xor(mx, 32));
        const float mn = fmaxf(m, mx);
        const float alpha = __builtin_amdgcn_exp2f(m - mn);
        float ls = 0.f;
#pragma unroll
        for (int r = 0; r < 16; ++r) { p0[r] = __builtin_amdgcn_exp2f(p0[r] - mn); p1[r] = __builtin_amdgcn_exp2f(p1[r] - mn); ls += p0[r] + p1[r]; }
        l = l * alpha + ls; m = mn;
        if (hi == 0) wsf[r32] = alpha;
        LDS_WAIT();
#pragma unroll
        for (int r = 0; r < 16; ++r) { const float a = wsf[crow(r, hi)]; o0[r] *= a; o1[r] *= a; }
        bf16x8 pa[4];
#pragma unroll
        for (int ks = 0; ks < 4; ++ks) {
            u32x4 w;
            if (ks < 2) { const int b = 8 * ks; w.x = pk2(p0[b], p0[b + 1]); w.y = pk2(p0[b + 2], p0[b + 3]); w.z = pk2(p0[b + 4], p0[b + 5]); w.w = pk2(p0[b + 6], p0[b + 7]); }
            else { const int b = 8 * (ks - 2); w.x = pk2(p1[b], p1[b + 1]); w.y = pk2(p1[b + 2], p1[b + 3]); w.z = pk2(p1[b + 4], p1[b + 5]); w.w = pk2(p1[b + 6], p1[b + 7]); }
            pa[ks] = __builtin_bit_cast(bf16x8, w);
        }
#pragma unroll
        for (int ks = 0; ks < 4; ++ks) {
            const int kb = 32 * (ks >> 1) + 16 * (ks & 1);
#pragma unroll
            for (int d0 = 0; d0 < 2; ++d0) {
                const s16x4 lo = vtr(vbase + kb * AT_PITCH + d0 * 64), hh = vtr(vbase + (kb + 8) * AT_PITCH + d0 * 64);
                const bf16x8 vf = {lo[0], lo[1], lo[2], lo[3], hh[0], hh[1], hh[2], hh[3]};
                if (d0 == 0) o0 = __builtin_amdgcn_mfma_f32_32x32x16_bf16(pa[ks], vf, o0, 0, 0, 0);
                else o1 = __builtin_amdgcn_mfma_f32_32x32x16_bf16(pa[ks], vf, o1, 0, 0, 0);
            }
        }
    }
    l += __shfl_xor(l, 32);
    if (u.has_sink) l += __builtin_amdgcn_exp2f(u.sink2 - m);
    LDS_WAIT();
    if (hi == 0) wsf[32 + r32] = l;
    LDS_WAIT();
#pragma unroll
    for (int r = 0; r < 16; ++r) { const int q = crow(r, hi); const float rl = 1.0f / wsf[32 + q];
        bf16_t* op = mix + (size_t)(u.qrow0 + wid * 32 + q) * DMIX + u.ocol + r32;
        op[0] = (bf16_t)f2bf(o0[r] * rl); op[32] = (bf16_t)f2bf(o1[r] * rl); }
    LDS_WAIT();
}
constexpr int CV_H = 0, CV_W = 49152;
__device__ __forceinline__ void conv_unit(Frame& F, int layer, int R0, int L, int t0, const bf16_t* proj, bf16_t* mix) {
    LAS unsigned char* hs = F.lds + CV_H; const LAS float* cw = (const LAS float*)(F.lds + CV_W);
    __syncthreads();
    for (int idx = F.tid; idx < 94 * 32; idx += 512) { const int row = idx >> 5, ch = idx & 31, tp = t0 - 15 + row;
        u32x4 v = {0u, 0u, 0u, 0u};
        if (tp >= 0 && tp < L) v = *(const u32x4*)(proj + (size_t)(R0 + tp) * DIN + C_BU + ch * 8);
        *(LAS u32x4*)(hs + row * 512 + ch * 16) = v; }
    __syncthreads();
    const int c4 = F.lane * 4;
    const f32x4 bias = *(const f32x4*)(F.in[I_CONVB] + layer * BCH + c4), lg = *(const f32x4*)(F.in[I_LNG] + layer * BCH + c4), lb = *(const f32x4*)(F.in[I_LNB] + layer * BCH + c4);
    for (int i = 0; i < 8; ++i) {
        const int tt = F.wave * 8 + i;
        f32x4 acc = bias;
#pragma unroll
        for (int k = 0; k < CONVW; ++k) { const u32x2 xr = *(const LAS u32x2*)(hs + (tt + k) * 512 + F.lane * 8); const f32x4 wv = *(const LAS f32x4*)(cw + k * 256 + c4);
            acc.x += bf2f(xr.x & 0xffffu) * wv.x; acc.y += bf2f(xr.x >> 16) * wv.y; acc.z += bf2f(xr.y & 0xffffu) * wv.z; acc.w += bf2f(xr.y >> 16) * wv.w; }
        const float mean = wave_sum((acc.x + acc.y) + (acc.z + acc.w)) * (1.0f / BCH);
        const f32x4 d = acc - mean;
        const float var = wave_sum((d.x * d.x + d.y * d.y) + (d.z * d.z + d.w * d.w)) * (1.0f / BCH);
        const f32x4 y = d * (1.0f / sqrtf(var + EPS)) * lg + lb;
        f32x4 s; s.x = y.x / (1.0f + __expf(-y.x)); s.y = y.y / (1.0f + __expf(-y.y)); s.z = y.z / (1.0f + __expf(-y.z)); s.w = y.w / (1.0f + __expf(-y.w));
        u32x2 o; o.x = pk2(s.x, s.y); o.y = pk2(s.z, s.w);
        *(u32x2*)(mix + (size_t)(R0 + t0 + tt) * DMIX + O_B + c4) = o;
    }
}
__device__ __forceinline__ void p4_mixers(Frame& F, int layer) {
    frame_ids(F);
    const bf16_t* proj = (const bf16_t*)(F.ws + WS_PROJ); bf16_t* mix = (bf16_t*)(F.ws + WS_H);
    const bool with_ctx = layer < DEPTH - 1;
    const int n_att = 3072 + (with_ctx ? 384 : 0);
    for (int un = F.vcu; un < n_att; un += F.G) {
        AttnUnit u; int kind, idx;
        if (un < 1536) { kind = 0; idx = un; } else if (un < 3072) { kind = 1; idx = un - 1536; } else if (un < 3264) { kind = 2; idx = un - 3072; } else { kind = 3; idx = un - 3264; }
        const bool isC = kind & 1, isctx = kind >= 2;
        int b, h, qb;
        if (!isctx) { qb = idx & 7; h = (idx >> 3) % 6; b = idx / 48; } else { qb = 0; h = idx % 6; b = idx / 6; }
        const int kvh = h / 3;
        u.qcol = (isC ? C_CQ : C_AQ) + h * 64; u.kcol = (isC ? C_CK : C_AK) + kvh * 64; u.vcol = (isC ? C_CV : C_AV) + kvh * 64; u.ocol = (isC ? O_C : O_A) + h * 64;
        u.krow_ctx = NLAT + b * CTXL;
        u.has_sink = isC; u.sink2 = isC ? F.in[I_SINK][layer * 6 + h] * LOG2E : 0.f;
        if (isctx) { u.qrow0 = NLAT + b * CTXL; u.qpos0 = 0; u.nband = 0; u.krow_band = 0; u.kpos0 = 0; u.masked = 0; }
        else {
            u.qrow0 = b * SEQ + qb * 256; u.qpos0 = qb * 256;
            if (isC) { const int ks = qb * 256 - 128 < 0 ? 0 : qb * 256 - 128, ke = qb * 256 + 384 > SEQ ? SEQ : qb * 256 + 384;
                u.kpos0 = ks; u.nband = (ke - ks) >> 6; u.krow_band = b * SEQ + ks; u.masked = 1; }
            else { u.kpos0 = 0; u.nband = SEQ / 64; u.krow_band = b * SEQ; u.masked = 0; }
        }
        attn_unit_v1(u, proj, mix, F.lds);
    }
    __syncthreads();
    { LAS float* cw = (LAS float*)(F.lds + CV_W);
      for (int idx = F.tid; idx < CONVW * BCH; idx += 512) cw[idx] = F.in[I_CONVW][layer * CONVW * BCH + idx]; }
    const int n_conv = 1024 + (with_ctx ? 128 : 0);
    for (int un = F.vcu; un < n_conv; un += F.G) {
        if (un < 1024) conv_unit(F, layer, (un >> 5) * SEQ, SEQ, (un & 31) * 64, proj, mix);
        else conv_unit(F, layer, NLAT + ((un - 1024) >> 2) * CTXL, CTXL, ((un - 1024) & 3) * 64, proj, mix);
    }
    __syncthreads();
}

__device__ __forceinline__ void p6_router(Frame& F, int layer, int nrows) {
    frame_ids(F);
    LAS float* Wt = (LAS float*)F.lds;
    LAS unsigned* rec = (LAS unsigned*)(F.lds + LDS_REC);
    LAS unsigned* hist = (LAS unsigned*)(F.lds + LDS_MISC) + 64; LAS unsigned* base = (LAS unsigned*)(F.lds + LDS_MISC) + 96;
    const float* wg = F.in[I_WGRP] + (size_t)layer * D * 4; const float* we = F.in[I_WEXP] + (size_t)layer * D * NE;
    for (int idx = F.tid; idx < 36 * 1024; idx += 512) { const int j = idx >> 10, k = idx & 1023; Wt[idx] = j < 4 ? wg[k * 4 + j] : we[k * NE + (j - 4)]; }
    if (F.tid < NE) hist[F.tid] = 0u;
    __syncthreads();
    const int rpb = (nrows + F.G - 1) / F.G, rbeg = F.vcu * rpb, rend = rbeg + rpb < nrows ? rbeg + rpb : nrows;
    const float* mod = (const float*)(F.ws + WS_MOD); bf16_t* H = (bf16_t*)(F.ws + WS_H);
    f32x4 g[4];
#pragma unroll
    for (int j = 0; j < 4; ++j) g[j] = *(const f32x4*)(F.in[I_N2G] + layer * D + 4 * F.lane + 256 * j);
    const float* bgp = F.in[I_BGRP] + layer * 4; const float* bep = F.in[I_BEXP] + layer * NE;
    for (int r0 = rbeg + 2 * F.wave; r0 < rend; r0 += 16) {
        f32x4 h[2][4];
#pragma unroll
        for (int q = 0; q < 2; ++q) {
            const int r = (r0 + q < rend) ? r0 + q : r0;
            const bool lat = r < NLAT; const int mrow = lat ? r / SEQ : BATCH;
            const float* xin = lat ? F.out + (size_t)r * D : (const float*)(F.ws + WS_XC) + (size_t)(r - NLAT) * D;
            f32x4 v[4]; float ss = 0.f;
#pragma unroll
            for (int j = 0; j < 4; ++j) { v[j] = *(const f32x4*)(xin + 4 * F.lane + 256 * j); ss += (v[j].x * v[j].x + v[j].y * v[j].y) + (v[j].z * v[j].z + v[j].w * v[j].w); }
            const float rstd = 1.0f / sqrtf(wave_sum(ss) * (1.0f / D) + EPS);
            const float* mp = mod + ((size_t)layer * 33 + mrow) * (NMOD * D) + 3 * D;
#pragma unroll
            for (int j = 0; j < 4; ++j) { const f32x4 sh = *(const f32x4*)(mp + 4 * F.lane + 256 * j), sc = *(const f32x4*)(mp + D + 4 * F.lane + 256 * j);
                h[q][j] = (v[j] * rstd * g[j]) * (sc + 1.0f) + sh;
                u32x2 o; o.x = pk2(h[q][j].x, h[q][j].y); o.y = pk2(h[q][j].z, h[q][j].w);
                if (q == 0 || r0 + 1 < rend) *(u32x2*)(H + (size_t)r * D + 4 * F.lane + 256 * j) = o; }
        }
        float ev[64], gv[8];
#pragma unroll
        for (int jj = 0; jj < 36; ++jj) {
            float a0 = 0.f, a1 = 0.f;
#pragma unroll
            for (int j = 0; j < 4; ++j) { const f32x4 w = *(const LAS f32x4*)(Wt + jj * 1024 + 4 * F.lane + 256 * j);
                a0 += (h[0][j].x * w.x + h[0][j].y * w.y) + (h[0][j].z * w.z + h[0][j].w * w.w);
                a1 += (h[1][j].x * w.x + h[1][j].y * w.y) + (h[1][j].z * w.z + h[1][j].w * w.w); }
            if (jj < 4) { gv[jj] = a0; gv[4 + jj] = a1; } else { ev[jj - 4] = a0; ev[32 + jj - 4] = a1; }
        }
#pragma unroll
        for (int s = 32, n = 64; s >= 1; s >>= 1, n >>= 1) {
            const bool up = (F.lane & s) != 0;
#pragma unroll
            for (int i = 0; i < n / 2; ++i) { const float keep = up ? ev[i + n / 2] : ev[i], send = up ? ev[i] : ev[i + n / 2]; ev[i] = keep + __shfl_xor(send, s); }
        }
#pragma unroll
        for (int s = 32, n = 8; s >= 8; s >>= 1, n >>= 1) {
            const bool up = (F.lane & s) != 0;
#pragma unroll
            for (int i = 0; i < n / 2; ++i) { const float keep = up ? gv[i + n / 2] : gv[i], send = up ? gv[i] : gv[i + n / 2]; gv[i] = keep + __shfl_xor(send, s); }
        }
        gv[0] += __shfl_xor(gv[0], 4); gv[0] += __shfl_xor(gv[0], 2); gv[0] += __shfl_xor(gv[0], 1);
        const float etot = ev[0], gtot = gv[0];
#pragma unroll
        for (int q = 0; q < 2; ++q) {
            if (q == 1 && r0 + 1 >= rend) break;
            float gl[4];
#pragma unroll
            for (int gi = 0; gi < 4; ++gi) gl[gi] = __shfl(gtot, (q * 4 + gi) * 8) + bgp[gi];
            int gidx = 0; float gmax = gl[0];
#pragma unroll
            for (int gi = 1; gi < 4; ++gi) if (gl[gi] > gmax) { gmax = gl[gi]; gidx = gi; }
            float gsum = 0.f;
#pragma unroll
            for (int gi = 0; gi < 4; ++gi) gsum += __expf(gl[gi] - gmax);
            const float gval = 1.0f / gsum;
            float el[8];
#pragma unroll
            for (int j = 0; j < 8; ++j) el[j] = __shfl(etot, q * 32 + gidx * 8 + j) + bep[gidx * 8 + j];
            int i0 = 0; float v0 = el[0];
#pragma unroll
            for (int j = 1; j < 8; ++j) if (el[j] > v0) { v0 = el[j]; i0 = j; }
            int i1 = -1; float v1 = -INFINITY;
#pragma unroll
            for (int j = 0; j < 8; ++j) if (j != i0 && el[j] > v1) { v1 = el[j]; i1 = j; }
            const float t = __expf(v1 - v0), w0 = gval / (1.0f + t), w1 = gval * t / (1.0f + t);
            if (F.lane == 0) {
                const int e0 = gidx * 8 + i0, e1 = gidx * 8 + i1;
                const unsigned x0 = atomicAdd((unsigned*)&hist[e0], 1u), x1 = atomicAdd((unsigned*)&hist[e1], 1u);
                LAS unsigned* rp = rec + (size_t)(r0 + q - rbeg) * 4;
                rp[0] = (unsigned)e0 | (x0 << 8); rp[1] = (unsigned)e1 | (x1 << 8); rp[2] = __float_as_uint(w0); rp[3] = __float_as_uint(w1);
            }
        }
    }
    __syncthreads();
    unsigned* cnt = (unsigned*)(F.ws + WS_CTL) + CW_CNT + layer * NE;
    if (F.tid < NE) base[F.tid] = hist[F.tid] ? atomicAdd(&cnt[F.tid], hist[F.tid]) : 0u;
    __syncthreads();
    int* tok = (int*)(F.ws + WS_TOK); u32x4* slot = (u32x4*)(F.ws + WS_SLOT);
    for (int i = F.tid; i < rend - rbeg; i += 512) {
        const LAS unsigned* rp = rec + (size_t)i * 4; const unsigned a = rp[0], b = rp[1];
        const unsigned e0 = a & 0xffu, e1 = b & 0xffu, p0 = base[e0] + (a >> 8), p1 = base[e1] + (b >> 8);
        tok[(size_t)e0 * TOKCAP + p0] = rbeg + i; tok[(size_t)e1 * TOKCAP + p1] = rbeg + i;
        u32x4 s; s.x = (e0 << 20) | p0; s.y = (e1 << 20) | p1; s.z = rp[2]; s.w = rp[3];
        slot[rbeg + i] = s;
    }
    __syncthreads();
}

__global__ void __launch_bounds__(512, 2) hymba_fwd(Args args) {
    extern __shared__ __attribute__((aligned(16))) unsigned char lds_raw[];
    Frame F;
    F.lds = (LAS unsigned char*)lds_raw;
    F.tid = threadIdx.x; F.lane = F.tid & 63; F.wave = __builtin_amdgcn_readfirstlane(F.tid >> 6);
    F.G = gridDim.x; { const int bx = blockIdx.x; F.vcu = (F.G % 8 == 0) ? (bx % 8) * (F.G / 8) + bx / 8 : bx; }
    F.in = args.in; F.out = args.out; F.ws = args.ws;
    for (int u = F.tid; u < 256; u += 512) ((LAS unsigned*)(F.lds + LDS_MISC))[u] = 0u;
    __syncthreads();
    const int lo = args.ph_lo, hi = args.ph_hi;
    XcdBarrier bar; bar.bar = (unsigned*)(F.ws + WS_CTL) + CW_BAR; bar.x = 0; bar.st = nullptr;
    if (hi - lo > 1) bar = xcd_barrier_post((unsigned*)(F.ws + WS_CTL) + CW_BAR, (volatile LAS unsigned*)(F.lds + LDS_MISC));
#ifndef ONLY_PH
#define ONLY_PH -1
#endif
#define IN(k) (lo <= (k) && (k) < hi)
#ifndef SKIP_MASK
#define SKIP_MASK 0
#endif
#define INL(j) ((ONLY_PH < 0 || ONLY_PH == 1 + (j)) && !((SKIP_MASK >> (1 + (j))) & 1) && IN(g0 + (j)))
#define SEAM(k) do { if ((k) + 1 < hi) xcd_barrier(bar); } while (0)
    bf16_t* const Hb = (bf16_t*)(F.ws + WS_H); bf16_t* const Pb = (bf16_t*)(F.ws + WS_PROJ); bf16_t* const Ab = (bf16_t*)(F.ws + WS_ACT);
    float* const XC = (float*)(F.ws + WS_XC); const float* const modp = (const float*)(F.ws + WS_MOD);
    const LAS int* tstart = (const LAS int*)(F.lds + LDS_MISC) + 16;

    if ((ONLY_PH < 0 || ONLY_PH == 0) && !(SKIP_MASK & 1) && IN(0)) { p0_prologue(F); SEAM(0); }
#pragma unroll 1
    for (int layer = 0; layer < DEPTH; ++layer) {
        const int g0 = 1 + NPH_LAYER * layer;
        const bool with_ctx = layer < DEPTH - 1;
        const int nrows = with_ctx ? MT : NLAT;
        if (INL(0)) { p_norm<0>(F, layer, layer - 1, MT); SEAM(g0 + 0); }
        if (INL(1)) {
            pg8::DenseOrder S; S.init(Hb, (const bf16_t*)(F.ws + WS_WIN) + (size_t)layer * DIN * D, MT, DIN, D, F.G, (int)blockIdx.x);
            pg8::EpiBf16 E{Pb, DIN};
            pg8::gemm_phase<pg8::EpiBf16, pg8::DenseOrder, false, true>(F.lds, D, S, E);
            SEAM(g0 + 1);
        }
        if (INL(2)) { p3_postproj(F, layer); SEAM(g0 + 2); }
        if (INL(3)) { p4_mixers(F, layer); SEAM(g0 + 3); }
        if (INL(4)) {
            pg8::DenseOrder S; S.init(Hb, (const bf16_t*)(F.ws + WS_WOUT) + (size_t)layer * D * DMIX, nrows, D, DMIX, F.G, (int)blockIdx.x);
            pg8::EpiResid E{layer == 0 ? F.in[I_X] : F.out, layer == 0 ? F.in[I_CTX] : XC, F.out, XC, modp + (size_t)layer * 33 * (NMOD * D) + 2 * D};
            pg8::gemm_phase<pg8::EpiResid, pg8::DenseOrder, false, true>(F.lds, DMIX, S, E);
            SEAM(g0 + 4);
        }
        if (INL(5)) { p6_router(F, layer, nrows); SEAM(g0 + 5); }
        if (INL(6)) {
            build_tstart(F, layer);
            pg8::MoeOrder S{Hb, (const bf16_t*)(F.ws + WS_WGU) + (size_t)layer * NE * 1024 * 1024, (size_t)1024 * 1024, D, 4, tstart, F.G, (int)blockIdx.x,
                            (const int*)(F.ws + WS_TOK), (const int*)((const unsigned*)(F.ws + WS_CTL) + CW_CNT + layer * NE)};
            pg8::EpiGlu E{Ab};
            pg8::gemm_phase<pg8::EpiGlu, pg8::MoeOrder, true, true>(F.lds, D, S, E);
            SEAM(g0 + 6);
        }
        if (INL(7)) {
            build_tstart(F, layer);
            pg8::MoeOrder S{Ab, (const bf16_t*)(F.ws + WS_WD) + (size_t)layer * NE * 1024 * DE, (size_t)1024 * DE, DE, 4, tstart, F.G, (int)blockIdx.x, nullptr, nullptr};
            pg8::EpiBf16 E{Pb, D};
            pg8::gemm_phase<pg8::EpiBf16, pg8::MoeOrder, false, true>(F.lds, DE, S, E);
            SEAM(g0 + 7);
        }
    }
    if ((ONLY_PH < 0 || ONLY_PH == 9) && !((SKIP_MASK >> 9) & 1) && IN(PH_FINAL)) { p_norm<1>(F, 0, DEPTH - 1, NLAT); }
#undef IN
#undef INL
#undef SEAM
}

extern "C" void kernel_launch(void* const* d_in, const int* in_sizes, int n_in, void* d_out, int out_size, void* d_ws, size_t ws_size, hipStream_t stream) {
    static int grid = 0;
    if (grid == 0) {
        if (n_in != N_IN || out_size != NLAT * D || ws_size < WS_END) { fprintf(stderr, "kernel_launch: unexpected shapes (n_in %d out %d ws %zu); nothing launched\n", n_in, out_size, ws_size); grid = -1; return; }
        int dev = 0, cus = 0;
        if (hipGetDevice(&dev) != hipSuccess || hipDeviceGetAttribute(&cus, hipDeviceAttributeMultiprocessorCount, dev) != hipSuccess) { grid = -1; return; }
        if (hipFuncSetAttribute((const void*)hymba_fwd, hipFuncAttributeMaxDynamicSharedMemorySize, LDS_BYTES) != hipSuccess) { fprintf(stderr, "kernel_launch: hipFuncSetAttribute failed\n"); grid = -1; return; }
        int per_cu = 0;
        if (hipOccupancyMaxActiveBlocksPerMultiprocessor(&per_cu, (const void*)hymba_fwd, 512, LDS_BYTES) != hipSuccess || per_cu < 1) { fprintf(stderr, "kernel_launch: occupancy query says %d\n", per_cu); }
        (void)hipGetLastError();
        grid = cus;
    }
    if (grid < 0) return;
    (void)hipMemsetAsync((char*)d_ws + WS_CTL, 0, CTL_ZERO_BYTES, stream);
    Args a{};
    for (int i = 0; i < N_IN; ++i) a.in[i] = (const float*)d_in[i];
    a.out = (float*)d_out; a.ws = (unsigned char*)d_ws;
#if MK_ONE_LAUNCH
    a.ph_lo = 0; a.ph_hi = NPHASES;
    hipLaunchKernelGGL(hymba_fwd, dim3(grid), dim3(512), LDS_BYTES, stream, a);
#else
    for (int p = 0; p < NPHASES; ++p) { a.ph_lo = p; a.ph_hi = p + 1; hipLaunchKernelGGL(hymba_fwd, dim3(grid), dim3(512), LDS_BYTES, stream, a); }
#endif
}
```

```cpp
#include <hip/hip_runtime.h>
#include <cstdint>
#include <cstdio>

#ifndef MK_ONE_LAUNCH
#define MK_ONE_LAUNCH 1
#endif

#define LAS __attribute__((address_space(3)))
#define GAS __attribute__((address_space(1)))
typedef unsigned short bf16_t;
typedef short bf16x8 __attribute__((ext_vector_type(8)));
typedef short s16x4 __attribute__((ext_vector_type(4)));
typedef float f32x4 __attribute__((ext_vector_type(4)));
typedef float f32x2 __attribute__((ext_vector_type(2)));
typedef float f32x16 __attribute__((ext_vector_type(16)));
typedef unsigned u32x4 __attribute__((ext_vector_type(4)));
typedef unsigned u32x2 __attribute__((ext_vector_type(2)));

constexpr int D = 1024, BATCH = 32, SEQ = 2048, DEPTH = 4, CTXL = 256, HD = 64;
constexpr int NLAT = BATCH * SEQ, NCTX = BATCH * CTXL, MT = NLAT + NCTX;
constexpr int DIN = 1792, DMIX = 1024, NMOD = 6;
constexpr int C_AQ = 0, C_AK = 384, C_AV = 512, C_BU = 640, C_BG = 896, C_CQ = 1152, C_CK = 1536, C_CV = 1664;
constexpr int O_A = 0, O_B = 384, O_C = 640;
constexpr int NE = 32, DE = 512, CONVW = 31, BCH = 256;
constexpr int TOKCAP = MT;
constexpr int NP_MAX = (2 * MT / 256 + NE) * 256;
constexpr float EPS = 1e-6f;
constexpr float LOG2E = 1.4426950408889634f;
constexpr float QSCALE = 0.125f * LOG2E;

constexpr size_t MiB = 1u << 20;
constexpr size_t WS_CTL = 0, CTL_ZERO_BYTES = 1 * MiB;
constexpr size_t WS_ROPE = 1 * MiB;
constexpr size_t WS_MOD = 2 * MiB;
constexpr size_t WS_WIN = 6 * MiB;
constexpr size_t WS_WOUT = 20 * MiB;
constexpr size_t WS_WGU = 28 * MiB;
constexpr size_t WS_WD = 284 * MiB;
constexpr size_t WS_XC = 412 * MiB;
constexpr size_t WS_H = 444 * MiB;
constexpr size_t WS_PROJ = 588 * MiB;
constexpr size_t WS_ACT = 892 * MiB;
constexpr size_t WS_TOK = 1044 * MiB;
constexpr size_t WS_SLOT = 1053 * MiB;
constexpr size_t WS_END = 1055 * MiB;
constexpr int CW_BAR = 4096;
constexpr int CW_CNT = 16384;

constexpr int LDS_BYTES = 155648;
constexpr int LDS_REC = 147456;
constexpr int LDS_MISC = 154624;

__device__ __forceinline__ float bf2f(unsigned b) { return __uint_as_float(b << 16); }
__device__ __forceinline__ unsigned f2bf(float f) { unsigned u = __float_as_uint(f); return (u + 0x7fffu + ((u >> 16) & 1u)) >> 16; }
__device__ __forceinline__ unsigned pk2(float lo, float hi) { return f2bf(lo) | (f2bf(hi) << 16); }
__device__ __forceinline__ float wave_sum(float v) {
#pragma unroll
    for (int o = 32; o >= 1; o >>= 1) v += __shfl_xor(v, o);
    return v;
}
#define LDS_WAIT() asm volatile("s_waitcnt lgkmcnt(0)" ::: "memory")
#define VM_WAIT() asm volatile("s_waitcnt vmcnt(0)" ::: "memory")

namespace pg8 {
constexpr int BM = 256, BK = 64, HALF = 128, HTB = HALF * BK * 2, STAGE_BYTES = 8 * HTB, NXCD = 8, WGM = 8;
__host__ __device__ __forceinline__ int lds_byte(int r, int c) { const int st = (r >> 4) * 2 + (c >> 5), rr = r & 15, cc = c & 31, ob = rr * 64 + cc * 2; return st * 1024 + (ob ^ (((ob >> 9) & 1) << 5)); }
__host__ __device__ __forceinline__ void stage_rc(int b, int& R, int& C) { const int st = b / 1024, sb = b % 1024, swz = sb ^ (((sb >> 9) & 1) << 5); R = (st >> 1) * 16 + swz / 64; C = (st & 1) * 32 + (swz % 64) / 2; }
__host__ __device__ __forceinline__ int perm32(int rho) { const int n = rho >> 4, i = rho & 15; return 8 * (i >> 2) + 4 * n + (i & 3); }

struct Unit { int pm, pn, e; };

struct DenseOrder {
    const bf16_t* A; const bf16_t* Bt; int K; int nM, nN, nwg, G, c;
    __device__ void init(const bf16_t* A_, const bf16_t* Bt_, int M, int N, int K_, int G_, int c_) { A = A_; Bt = Bt_; K = K_; nM = M / BM; nN = N / BM; nwg = nM * nN; G = G_; c = c_; }
    __device__ __forceinline__ bool next(int i, Unit& u) const {
        const long L = (long)i * G + c; if (L >= nwg) return false;
        int wgid = (int)L; { const int q = nwg / NXCD, r = nwg % NXCD, xcd = wgid % NXCD, off = wgid / NXCD; wgid = (xcd < r ? xcd * (q + 1) : r * (q + 1) + (xcd - r) * q) + off; }
        const int nig = WGM * nN, gid = wgid / nig, fm = gid * WGM, gsz = (nM - fm) < WGM ? (nM - fm) : WGM;
        u.pm = fm + ((wgid % nig) % gsz); u.pn = (wgid % nig) / gsz; u.e = 0; return true;
    }
    __device__ __forceinline__ const char* a_base(const Unit& u) const { return (const char*)A + (size_t)u.pm * BM * K * 2; }
    __device__ __forceinline__ const char* b_base(const Unit& u) const { return (const char*)Bt + (size_t)u.pn * BM * K * 2; }
    __device__ __forceinline__ unsigned row_off(const Unit&, int) const { return 0u; }
};
struct MoeOrder {
    const bf16_t* A; const bf16_t* W; size_t wstride; int K; int ncol; const LAS int* tstart; int G, c;
    const int* tok; const int* cnt;
    __device__ __forceinline__ bool next(int i, Unit& u) const {
        const long L = (long)i * G + c; const int nt = tstart[NE];
        if (L >= (long)nt * ncol) return false;
        u.pm = (int)(L / ncol); u.pn = (int)(L % ncol);
        int e = 0;
#pragma unroll 1
        for (; e < NE - 1; ++e) if (tstart[e + 1] > u.pm) break;
        u.e = e; return true;
    }
    __device__ __forceinline__ const char* a_base(const Unit& u) const { return (const char*)A + (tok ? (size_t)0 : (size_t)u.pm * BM * K * 2); }
    __device__ __forceinline__ const char* b_base(const Unit& u) const { return (const char*)W + ((size_t)u.e * wstride + (size_t)u.pn * BM * K) * 2; }
    __device__ __forceinline__ unsigned row_off(const Unit& u, int r) const {
        const int n = cnt[u.e]; int p = (u.pm - tstart[u.e]) * BM + r; p = p < n ? p : n - 1;
        return (unsigned)tok[(size_t)u.e * TOKCAP + p] * (unsigned)(K * 2);
    }
};

__device__ __forceinline__ unsigned cvt_pk_bf16(float lo, float hi) { unsigned r; asm volatile("v_cvt_pk_bf16_f32 %0, %1, %2" : "=v"(r) : "v"(lo), "v"(hi)); return r; }

struct EpiBf16 {
    static constexpr bool PERM = true;
    bf16_t* O; int ldc;
    __device__ __forceinline__ void operator()(const f32x4 (&acc)[2][2][4][2], const Unit& u, int wr, int wc, int fr, int fq) const {
        const int row0 = u.pm * BM + wr * 64 + fr, col0 = u.pn * BM + wc * 32 + 8 * fq;
#pragma unroll
        for (int ai = 0; ai < 2; ++ai)
#pragma unroll
            for (int m = 0; m < 4; ++m) { bf16_t* rowp = O + (size_t)(row0 + ai * HALF + m * 16) * ldc + col0;
#pragma unroll
                for (int bj = 0; bj < 2; ++bj) { const f32x4 v0 = acc[ai][bj][m][0], v1 = acc[ai][bj][m][1];
                    u32x4 w; w.x = cvt_pk_bf16(v0[0], v0[1]); w.y = cvt_pk_bf16(v0[2], v0[3]); w.z = cvt_pk_bf16(v1[0], v1[1]); w.w = cvt_pk_bf16(v1[2], v1[3]);
                    *(u32x4*)(rowp + bj * HALF) = w; } }
    }
};
struct EpiGlu {
    static constexpr bool PERM = true;
    bf16_t* O;
    __device__ __forceinline__ void operator()(const f32x4 (&acc)[2][2][4][2], const Unit& u, int wr, int wc, int fr, int fq) const {
        const int row0 = u.pm * BM + wr * 64 + fr, col0 = u.pn * HALF + wc * 32 + 8 * fq;
#pragma unroll
        for (int ai = 0; ai < 2; ++ai)
#pragma unroll
            for (int m = 0; m < 4; ++m) { bf16_t* rowp = O + (size_t)(row0 + ai * HALF + m * 16) * DE + col0;
                float r[8];
#pragma unroll
                for (int n = 0; n < 2; ++n)
#pragma unroll
                    for (int i = 0; i < 4; ++i) { const float g = acc[ai][0][m][n][i], up = acc[ai][1][m][n][i];
                        r[n * 4 + i] = g * __builtin_amdgcn_rcpf(1.0f + __builtin_amdgcn_exp2f(-g * LOG2E)) * up; }
                u32x4 w; w.x = cvt_pk_bf16(r[0], r[1]); w.y = cvt_pk_bf16(r[2], r[3]); w.z = cvt_pk_bf16(r[4], r[5]); w.w = cvt_pk_bf16(r[6], r[7]);
                *(u32x4*)rowp = w; }
    }
};
struct EpiResid {
    static constexpr bool PERM = false;
    const float* xin_lat; const float* xin_ctx; float* xout_lat; float* xout_ctx; const float* gate;
    __device__ __forceinline__ void operator()(const f32x4 (&acc)[2][2][4][2], const Unit& u, int wr, int wc, int fr, int fq) const {
        const int col0 = u.pn * BM + wc * 32 + 4 * fq;
        const bool lat = u.pm < NLAT / BM;
        const int mrow = lat ? (u.pm >> 3) : BATCH;
        const size_t rbase = lat ? (size_t)u.pm * BM : (size_t)u.pm * BM - NLAT;
        const float* xin = lat ? xin_lat : xin_ctx; float* xout = lat ? xout_lat : xout_ctx;
        f32x4 gv[2][2];
#pragma unroll
        for (int bj = 0; bj < 2; ++bj)
#pragma unroll
            for (int n = 0; n < 2; ++n) gv[bj][n] = *(const f32x4*)(gate + (size_t)mrow * (NMOD * D) + col0 + bj * HALF + n * 16);
#pragma unroll
        for (int ai = 0; ai < 2; ++ai)
#pragma unroll
            for (int m = 0; m < 4; ++m) { const size_t off = (rbase + ai * HALF + wr * 64 + m * 16 + fr) * D + col0;
#pragma unroll
                for (int bj = 0; bj < 2; ++bj)
#pragma unroll
                    for (int n = 0; n < 2; ++n) { const f32x4 xi = *(const f32x4*)(xin + off + bj * HALF + n * 16);
                        *(f32x4*)(xout + off + bj * HALF + n * 16) = xi + gv[bj][n] * acc[ai][bj][m][n]; } }
    }
};

template <class Epi, class Sched, bool GATHER, bool ALIGN_EPI>
__device__ __forceinline__ void gemm_phase(LAS unsigned char* lds, const int K, const Sched& S, const Epi& E) {
    int tid = threadIdx.x; asm volatile("" : "+v"(tid));
    const int wid = __builtin_amdgcn_readfirstlane(tid >> 6), lane = tid & 63, wr = wid >> 2, wc = wid & 3, fr = lane & 15, fq = lane >> 4;
    const int nt = K / BK;
    unsigned voffA[2], voffB[2]; int sR[2], sC2[2];
#pragma unroll
    for (int i = 0; i < 2; ++i) { int R, C; stage_rc(tid * 16 + i * 8192, R, C); const int Rb = Epi::PERM ? ((R & ~31) + perm32(R & 31)) : R;
        voffA[i] = (unsigned)(R * K + C) * 2u; voffB[i] = (unsigned)(Rb * K + C) * 2u; sR[i] = R; sC2[i] = C * 2; }
    const size_t kstep = (size_t)(BK * 2);
    const size_t hstep = (size_t)HALF * K * 2;
    const unsigned ldsw = (unsigned)wid * 1024u;
    const int aoff = lds_byte(wr * 64 + fr, fq * 8), boff = lds_byte(wc * 32 + fr, fq * 8);
#define PG8_SA(b, h) (((b) * 2 + (h)) * HTB)
#define PG8_SB(b, h) ((4 + (b) * 2 + (h)) * HTB)
#define PG8_STAGE(bufoff, gbase, voff) do { _Pragma("unroll") for (int _i = 0; _i < 2; ++_i) \
        __builtin_amdgcn_global_load_lds((const unsigned*)((const char*)(gbase) + (voff)[_i]), (LAS unsigned*)(lds + (bufoff) + ldsw + _i * 8192), 16, 0, 0); } while (0)
#define PG8_STAGE_A(bufoff, kp, h, O0, O1) do { if constexpr (GATHER) { if ((h) == 0) PG8_STAGE(bufoff, kp, O0); else PG8_STAGE(bufoff, kp, O1); } else { PG8_STAGE(bufoff, (kp) + (h) * hstep, voffA); } } while (0)
#define PG8_LDA(dst, b, h) do { _Pragma("unroll") for (int m = 0; m < 4; ++m) _Pragma("unroll") for (int k = 0; k < 2; ++k) dst[m][k] = *(const LAS bf16x8*)(lds + PG8_SA(b, h) + aoff + m * 2048 + k * 1024); } while (0)
#define PG8_LDB(dst, b, h) do { _Pragma("unroll") for (int n = 0; n < 2; ++n) _Pragma("unroll") for (int k = 0; k < 2; ++k) dst[n][k] = *(const LAS bf16x8*)(lds + PG8_SB(b, h) + boff + n * 2048 + k * 1024); } while (0)
#define PG8_MMA(ai, bj, At, Bt) do { __builtin_amdgcn_s_setprio(1); _Pragma("unroll") for (int m = 0; m < 4; ++m) _Pragma("unroll") for (int n = 0; n < 2; ++n) _Pragma("unroll") for (int k = 0; k < 2; ++k) \
        acc[ai][bj][m][n] = __builtin_amdgcn_mfma_f32_16x16x32_bf16(Bt[n][k], At[m][k], acc[ai][bj][m][n], 0, 0, 0); __builtin_amdgcn_s_setprio(0); } while (0)
#define PG8_WAIT_V(n) asm volatile("s_waitcnt vmcnt(" #n ")" ::: "memory")
#define PG8_WAIT_L(n) asm volatile("s_waitcnt lgkmcnt(" #n ")" ::: "memory")
#define PG8_BAR __builtin_amdgcn_s_barrier()
#define PG8_SCHED __builtin_amdgcn_sched_barrier(0)
    Unit cur, nxt; int ui = 0;
    if (!S.next(0, cur)) return;
    f32x4 acc[2][2][4][2];
#pragma unroll
    for (int a = 0; a < 2; ++a)
#pragma unroll
        for (int b = 0; b < 2; ++b)
#pragma unroll
            for (int m = 0; m < 4; ++m)
#pragma unroll
                for (int n = 0; n < 2; ++n) acc[a][b][m][n] = (f32x4){0.f, 0.f, 0.f, 0.f};
    bf16x8 At[4][2], B0[2][2], B1[2][2];
    const char* cA = S.a_base(cur); const char* cB = S.b_base(cur);
    unsigned ca0[2] = {0u, 0u}, ca1[2] = {0u, 0u}, na0[2] = {0u, 0u}, na1[2] = {0u, 0u};
    if constexpr (GATHER) {
#pragma unroll
        for (int i = 0; i < 2; ++i) { ca0[i] = S.row_off(cur, sR[i]) + (unsigned)sC2[i]; ca1[i] = S.row_off(cur, HALF + sR[i]) + (unsigned)sC2[i]; }
    }
    PG8_STAGE(PG8_SB(0, 0), cB, voffB); PG8_STAGE(PG8_SB(0, 1), cB + hstep, voffB); PG8_STAGE_A(PG8_SA(0, 0), cA, 0, ca0, ca1); PG8_STAGE_A(PG8_SA(0, 1), cA, 1, ca0, ca1);
    if (wr == 1) PG8_BAR;
    PG8_WAIT_V(2); PG8_BAR;
    PG8_STAGE(PG8_SB(1, 0), cB + kstep, voffB); PG8_STAGE_A(PG8_SA(1, 0), cA + kstep, 0, ca0, ca1); PG8_STAGE(PG8_SB(1, 1), cB + hstep + kstep, voffB);
    PG8_WAIT_V(6); PG8_BAR;
    for (;;) {
        const bool has_next = S.next(ui + 1, nxt);
        const char* nA = has_next ? S.a_base(nxt) : cA; const char* nB = has_next ? S.b_base(nxt) : cB;
        if constexpr (GATHER) {
            if (has_next) {
#pragma unroll
                for (int i = 0; i < 2; ++i) { na0[i] = S.row_off(nxt, sR[i]) + (unsigned)sC2[i]; na1[i] = S.row_off(nxt, HALF + sR[i]) + (unsigned)sC2[i]; }
            } else { na0[0] = ca0[0]; na0[1] = ca0[1]; na1[0] = ca1[0]; na1[1] = ca1[1]; }
        }
        for (int t = 0; t < nt; t += 2) {
            const bool last = (t == nt - 2);
            const char* a1 = cA + (size_t)(t + 1) * kstep;
            const char* a2 = last ? nA : cA + (size_t)(t + 2) * kstep; const char* b2 = last ? nB : cB + (size_t)(t + 2) * kstep;
            const char* a3 = a2 + kstep; const char* b3 = b2 + kstep;
            unsigned x0[2], x1[2];
            x0[0] = last ? na0[0] : ca0[0]; x0[1] = last ? na0[1] : ca0[1]; x1[0] = last ? na1[0] : ca1[0]; x1[1] = last ? na1[1] : ca1[1];
            PG8_LDB(B0, 0, 0); PG8_LDB(B1, 0, 1); PG8_SCHED; PG8_LDA(At, 0, 0); PG8_STAGE_A(PG8_SA(1, 1), a1, 1, ca0, ca1);
            PG8_WAIT_V(8); PG8_WAIT_L(0); PG8_BAR; PG8_MMA(0, 0, At, B0); PG8_MMA(0, 1, At, B1); PG8_BAR; PG8_SCHED;
            PG8_LDA(At, 0, 1); PG8_STAGE(PG8_SB(0, 0), b2, voffB); PG8_STAGE(PG8_SB(0, 1), b2 + hstep, voffB); PG8_STAGE_A(PG8_SA(0, 0), a2, 0, x0, x1);
            PG8_WAIT_V(8); PG8_WAIT_L(0); PG8_BAR; PG8_MMA(1, 0, At, B0); PG8_MMA(1, 1, At, B1); PG8_BAR; PG8_SCHED;
            PG8_LDB(B0, 1, 0); PG8_LDB(B1, 1, 1); PG8_SCHED; PG8_LDA(At, 1, 0); PG8_STAGE_A(PG8_SA(0, 1), a2, 1, x0, x1);
            PG8_WAIT_V(8); PG8_WAIT_L(0); PG8_BAR; PG8_MMA(0, 0, At, B0); PG8_MMA(0, 1, At, B1); PG8_BAR; PG8_SCHED;
            PG8_LDA(At, 1, 1); PG8_STAGE(PG8_SB(1, 0), b3, voffB); PG8_STAGE(PG8_SB(1, 1), b3 + hstep, voffB); PG8_STAGE_A(PG8_SA(1, 0), a3, 0, x0, x1);
            PG8_WAIT_V(8); PG8_WAIT_L(0); PG8_BAR; PG8_MMA(1, 0, At, B0); PG8_MMA(1, 1, At, B1); PG8_BAR; PG8_SCHED;
        }
        if constexpr (ALIGN_EPI) { if (wr == 0) PG8_BAR; }
        E(acc, cur, wr, wc, fr, fq);
        if (!has_next) break;
#pragma unroll
        for (int a = 0; a < 2; ++a)
#pragma unroll
            for (int b = 0; b < 2; ++b)
#pragma unroll
                for (int m = 0; m < 4; ++m)
#pragma unroll
                    for (int n = 0; n < 2; ++n) acc[a][b][m][n] = (f32x4){0.f, 0.f, 0.f, 0.f};
        cur = nxt; cA = nA; cB = nB; ++ui;
        if constexpr (GATHER) { ca0[0] = na0[0]; ca0[1] = na0[1]; ca1[0] = na1[0]; ca1[1] = na1[1]; }
        if constexpr (ALIGN_EPI) { if (wr == 1) PG8_BAR; }
    }
    PG8_WAIT_V(0);
    if constexpr (!ALIGN_EPI) { if (wr == 0) PG8_BAR; }
    PG8_BAR;
#undef PG8_SA
#undef PG8_SB
#undef PG8_STAGE
#undef PG8_STAGE_A
#undef PG8_LDA
#undef PG8_LDB
#undef PG8_MMA
#undef PG8_WAIT_V
#undef PG8_WAIT_L
#undef PG8_BAR
#undef PG8_SCHED
}
}

#define XB_TMO      128
#define XB_XCNT(j)  (256  + 64 * (j))
#define XB_XSUB(j)  (1280 + 64 * (j))
#define XB_XGEN(j)  (2304 + 64 * (j))
#define XB_TOP      3328
#define XB_TOPGEN   3392
#define XCD_BAR_WORDS 3456
#define XB_SPIN_CAP (1u << 22)
__device__ __forceinline__ unsigned xb_ld(unsigned* p)              { return __hip_atomic_load(p, __ATOMIC_RELAXED, __HIP_MEMORY_SCOPE_AGENT); }
__device__ __forceinline__ unsigned xb_add(unsigned* p, unsigned v) { return __hip_atomic_fetch_add(p, v, __ATOMIC_RELAXED, __HIP_MEMORY_SCOPE_AGENT); }
__device__ __forceinline__ unsigned xb_xcc_id() { return (unsigned)__builtin_amdgcn_s_getreg((3 << 11) | 20) & 0xFu; }
#define XB_SPIN(cond, bar) do { unsigned _sp = 0; while (cond) { __builtin_amdgcn_s_sleep(1); \
    if ((++_sp & 255u) == 0u) { if (xb_ld(&(bar)[XB_TMO])) break; if (_sp > XB_SPIN_CAP) { atomicAdd(&(bar)[XB_TMO], 1u); break; } } } } while (0)
struct XcdBarrier { unsigned* bar; unsigned x; volatile LAS unsigned* st; };
__device__ __forceinline__ XcdBarrier xcd_barrier_post(unsigned* bar, volatile LAS unsigned* st) {
    XcdBarrier b; b.bar = bar; b.x = xb_xcc_id(); b.st = st;
    if (threadIdx.x == 0) (void)xb_add(&bar[XB_XCNT(b.x)], 1u);
    return b;
}
__device__ __forceinline__ void xcd_barrier_complete(unsigned* bar, unsigned x, unsigned& nloc, unsigned& nx) {
    const unsigned G = gridDim.x * gridDim.y * gridDim.z;
    unsigned sum, cnt, mine, sp = 0u;
    for (;;) {
        sum = 0u; cnt = 0u; mine = 0u;
#pragma unroll
        for (unsigned j = 0; j < 16; ++j) { const unsigned c = xb_ld(&bar[XB_XCNT(j)]); sum += c; cnt += (c > 0u) ? 1u : 0u; mine = (j == x) ? c : mine; }
        if (sum == G) break;
        __builtin_amdgcn_s_sleep(1);
        if ((++sp & 255u) == 0u) { if (xb_ld(&bar[XB_TMO])) break; if (sp > XB_SPIN_CAP) { atomicAdd(&bar[XB_TMO], 1u); break; } }
    }
    nloc = mine > 0u ? mine : 1u; nx = cnt > 0u ? cnt : 1u;
}
__device__ __forceinline__ void xcd_barrier(const XcdBarrier& b) {
    asm volatile("s_waitcnt vmcnt(0)" ::: "memory");
    __syncthreads();
    if (threadIdx.x == 0) {
        unsigned* bar = b.bar;
        __builtin_amdgcn_s_waitcnt(0);
        unsigned nloc = b.st[0], nx = b.st[1];
        if (nloc == 0u) { xcd_barrier_complete(bar, b.x, nloc, nx); b.st[0] = nloc; b.st[1] = nx; }
        const unsigned old = xb_add(&bar[XB_XSUB(b.x)], 1u);
        const unsigned gen = old / nloc;
        if (old + 1u == (gen + 1u) * nloc) {
            __builtin_amdgcn_fence(__ATOMIC_RELEASE, "agent");
            asm volatile("s_waitcnt vmcnt(0)" ::: "memory");
            const unsigned og = xb_add(&bar[XB_TOP], 1u);
            const unsigned tg = og / nx;
            if (og + 1u == (tg + 1u) * nx) xb_add(&bar[XB_TOPGEN], 1u);
            else XB_SPIN(xb_ld(&bar[XB_TOPGEN]) == tg, bar);
            __builtin_amdgcn_fence(__ATOMIC_ACQUIRE, "agent");
            xb_add(&bar[XB_XGEN(b.x)], 1u);
            asm volatile("s_waitcnt vmcnt(0)" ::: "memory");
        } else {
            XB_SPIN(xb_ld(&bar[XB_XGEN(b.x)]) == gen, bar);
            __builtin_amdgcn_fence(__ATOMIC_ACQUIRE, "agent");
            asm volatile("s_waitcnt vmcnt(0)" ::: "memory");
        }
    }
    __syncthreads();
}

enum { I_X = 0, I_C, I_CTX, I_CCTX, I_N1G, I_N2G, I_WMOD, I_BMOD, I_WIN, I_QG, I_KG, I_CONVW, I_CONVB, I_LNG, I_LNB, I_SINK, I_WOUT, I_WGRP, I_BGRP, I_WEXP, I_BEXP, I_WGATE, I_WUP, I_WDOWN, I_FING, N_IN };
struct Args { const float* in[N_IN]; float* out; unsigned char* ws; int ph_lo, ph_hi; };
struct Frame {
    LAS unsigned char* lds;
    int tid, lane, wave, G, vcu;
    const float* const* in; float* out; unsigned char* ws;
};
__device__ __forceinline__ void frame_ids(Frame& F) { int t = threadIdx.x; asm volatile("" : "+v"(t)); F.tid = t; F.lane = t & 63; F.wave = __builtin_amdgcn_readfirstlane(t >> 6); }
constexpr int NPH_LAYER = 8, PH_FINAL = 1 + NPH_LAYER * DEPTH, NPHASES = PH_FINAL + 1;

__device__ __forceinline__ void transpose_item(const float* W, int K, int N, int k0, int n0, bf16_t* dst_rows, LAS float* scr, int lane) {
#pragma unroll 8
    for (int i = 0; i < 32; ++i) { const int kk = 2 * i + (lane >> 5); scr[kk * 33 + (lane & 31)] = W[(size_t)(k0 + kk) * N + n0 + (lane & 31)]; }
    LDS_WAIT();
    const int c = lane & 7;
#pragma unroll
    for (int j = 0; j < 4; ++j) { const int n = (lane >> 3) + 8 * j; const LAS float* s = scr + (8 * c) * 33 + n;
        u32x4 o; o.x = pk2(s[0 * 33], s[1 * 33]); o.y = pk2(s[2 * 33], s[3 * 33]); o.z = pk2(s[4 * 33], s[5 * 33]); o.w = pk2(s[6 * 33], s[7 * 33]);
        *(u32x4*)(dst_rows + (size_t)n * K + k0 + 8 * c) = o; }
    LDS_WAIT();
}
__device__ __forceinline__ void p0_prologue(Frame& F) {
    frame_ids(F);
    LAS float* scr = (LAS float*)(F.lds + F.wave * 16384);
    const int gw = F.vcu * 8 + F.wave, NGW = F.G * 8;
    bf16_t* Win_t = (bf16_t*)(F.ws + WS_WIN); bf16_t* Wout_t = (bf16_t*)(F.ws + WS_WOUT); bf16_t* Wgu_t = (bf16_t*)(F.ws + WS_WGU); bf16_t* Wd_t = (bf16_t*)(F.ws + WS_WD);
    constexpr int T_IN = DEPTH * 16 * 56, T_OUT = DEPTH * 16 * 32, T_G = DEPTH * NE * 16 * 16, T_D = DEPTH * NE * 8 * 32;
    constexpr int NITEMS = T_IN + T_OUT + 2 * T_G + T_D;
    for (int it = gw; it < NITEMS; it += NGW) {
        int r = it;
        if (r < T_IN) { const int l = r / 896, q = r % 896, kb = q / 56, nb = q % 56;
            transpose_item(F.in[I_WIN] + (size_t)l * D * DIN, D, DIN, 64 * kb, 32 * nb, Win_t + ((size_t)l * DIN + 32 * nb) * D, scr, F.lane); continue; }
        r -= T_IN;
        if (r < T_OUT) { const int l = r / 512, q = r % 512, kb = q / 32, nb = q % 32;
            transpose_item(F.in[I_WOUT] + (size_t)l * DMIX * D, DMIX, D, 64 * kb, 32 * nb, Wout_t + ((size_t)l * D + 32 * nb) * DMIX, scr, F.lane); continue; }
        r -= T_OUT;
        if (r < 2 * T_G) { const int up = r >= T_G; if (up) r -= T_G; const int mat = r / 256, q = r % 256, kb = q / 16, nb = q % 16, n0 = 32 * nb;
            const int drow = 256 * (n0 / 128) + (n0 % 128) + (up ? 128 : 0);
            transpose_item(F.in[up ? I_WUP : I_WGATE] + (size_t)mat * D * DE, D, DE, 64 * kb, n0, Wgu_t + ((size_t)mat * 1024 + drow) * D, scr, F.lane); continue; }
        r -= 2 * T_G;
        { const int mat = r / 256, q = r % 256, kb = q / 32, nb = q % 32;
            transpose_item(F.in[I_WDOWN] + (size_t)mat * DE * D, DE, D, 64 * kb, 32 * nb, Wd_t + ((size_t)mat * D + 32 * nb) * DE, scr, F.lane); }
    }
    { float* rope = (float*)(F.ws + WS_ROPE); const int gt = F.vcu * 512 + F.tid;
      if (gt < 1024) { const int pos = gt >> 4, f = gt & 15; const float inv = powf(10000.0f, -(float)f / 16.0f); const float ang = (float)pos * inv; rope[gt] = cosf(ang); rope[1024 + gt] = sinf(ang); } }
    __syncthreads();
    { LAS float* sc = (LAS float*)F.lds;
      float* mod = (float*)(F.ws + WS_MOD);
      for (int un = F.vcu; un < DEPTH * 192; un += F.G) {
          const int l = un / 192, n0 = (un % 192) * 32;
          for (int idx = F.tid; idx < 33 * 1024; idx += 512) { const int r = idx >> 10, k = idx & 1023; const float v = r < 32 ? F.in[I_C][r * 1024 + k] : F.in[I_CCTX][k]; sc[idx] = v / (1.0f + __expf(-v)); }
          __syncthreads();
          const int col = F.tid & 31, kg = F.tid >> 5;
          float acc[33];
#pragma unroll
          for (int r = 0; r < 33; ++r) acc[r] = 0.f;
          const float* wp = F.in[I_WMOD] + ((size_t)l * D + kg * 64) * (NMOD * D) + n0 + col;
          for (int k = 0; k < 64; ++k) { const float w = wp[(size_t)k * (NMOD * D)];
#pragma unroll
              for (int r = 0; r < 33; ++r) acc[r] += sc[r * 1024 + kg * 64 + k] * w; }
#pragma unroll
          for (int r = 0; r < 33; ++r) acc[r] += __shfl_xor(acc[r], 32);
          __syncthreads();
          LAS float* red = (LAS float*)F.lds;
          if (F.lane < 32) {
#pragma unroll
              for (int r = 0; r < 33; ++r) red[(F.wave * 33 + r) * 32 + col] = acc[r]; }
          __syncthreads();
          for (int idx = F.tid; idx < 33 * 32; idx += 512) { const int r = idx >> 5, cc = idx & 31; float s = 0.f;
#pragma unroll
              for (int w = 0; w < 8; ++w) s += red[(w * 33 + r) * 32 + cc];
              mod[((size_t)l * 33 + r) * (NMOD * D) + n0 + cc] = s + F.in[I_BMOD][l * (NMOD * D) + n0 + cc]; }
          __syncthreads();
      }
    }
}

__device__ __forceinline__ void build_tstart(Frame& F, int layer) {
    frame_ids(F);
    LAS int* ts = (LAS int*)(F.lds + LDS_MISC) + 16;
    if (F.tid == 0) { const unsigned* cnt = (const unsigned*)(F.ws + WS_CTL) + CW_CNT + layer * NE; int s = 0;
        for (int e = 0; e < NE; ++e) { ts[e] = s; s += ((int)cnt[e] + 255) >> 8; } ts[NE] = s; }
    __syncthreads();
}
template <int MODE>
__device__ __forceinline__ void p_norm(Frame& F, int layer, int comb_layer, int nrows) {
    frame_ids(F);
    const int gw = F.vcu * 8 + F.wave, NGW = F.G * 8;
    const float* mod = (const float*)(F.ws + WS_MOD);
    const bf16_t* Y = (const bf16_t*)(F.ws + WS_PROJ);
    const u32x4* slot = (const u32x4*)(F.ws + WS_SLOT);
    bf16_t* H = (bf16_t*)(F.ws + WS_H);
    const LAS int* ts = (const LAS int*)(F.lds + LDS_MISC) + 16;
    if (comb_layer >= 0) build_tstart(F, comb_layer);
    const float* gptr = MODE == 0 ? F.in[I_N1G] + layer * D : F.in[I_FING];
    f32x4 g[4];
#pragma unroll
    for (int j = 0; j < 4; ++j) g[j] = *(const f32x4*)(gptr + 4 * F.lane + 256 * j);
    for (int r = gw; r < nrows; r += NGW) {
        const bool lat = r < NLAT; const int mrow = lat ? r / SEQ : BATCH;
        const float* xin; float* xout;
        if (lat) { xout = F.out + (size_t)r * D; xin = (layer == 0 && MODE == 0) ? F.in[I_X] + (size_t)r * D : xout; }
        else { xout = (float*)(F.ws + WS_XC) + (size_t)(r - NLAT) * D; xin = (layer == 0 && MODE == 0) ? F.in[I_CTX] + (size_t)(r - NLAT) * D : xout; }
        f32x4 v[4];
#pragma unroll
        for (int j = 0; j < 4; ++j) v[j] = *(const f32x4*)(xin + 4 * F.lane + 256 * j);
        if (comb_layer >= 0) {
            const u32x4 si = slot[r];
            const int e0 = si.x >> 20, e1 = si.y >> 20;
            const size_t p0 = (size_t)ts[e0] * 256 + (si.x & 0xfffffu), p1 = (size_t)ts[e1] * 256 + (si.y & 0xfffffu);
            const float w0 = __uint_as_float(si.z), w1 = __uint_as_float(si.w);
            const float* g2 = mod + ((size_t)comb_layer * 33 + mrow) * (NMOD * D) + 5 * D;
#pragma unroll
            for (int j = 0; j < 4; ++j) {
                const u32x2 a = *(const u32x2*)(Y + p0 * D + 4 * F.lane + 256 * j), b = *(const u32x2*)(Y + p1 * D + 4 * F.lane + 256 * j);
                const f32x4 gg = *(const f32x4*)(g2 + 4 * F.lane + 256 * j);
                f32x4 ya = {bf2f(a.x & 0xffffu), bf2f(a.x >> 16), bf2f(a.y & 0xffffu), bf2f(a.y >> 16)};
                f32x4 yb = {bf2f(b.x & 0xffffu), bf2f(b.x >> 16), bf2f(b.y & 0xffffu), bf2f(b.y >> 16)};
                v[j] = v[j] + gg * (ya * w0 + yb * w1);
                if (MODE == 0) *(f32x4*)(xout + 4 * F.lane + 256 * j) = v[j];
            }
        }
        float ss = 0.f;
#pragma unroll
        for (int j = 0; j < 4; ++j) ss += (v[j].x * v[j].x + v[j].y * v[j].y) + (v[j].z * v[j].z + v[j].w * v[j].w);
        const float rstd = 1.0f / sqrtf(wave_sum(ss) * (1.0f / D) + EPS);
        if (MODE == 0) {
            const float* mp = mod + ((size_t)layer * 33 + mrow) * (NMOD * D);
#pragma unroll
            for (int j = 0; j < 4; ++j) { const f32x4 sh = *(const f32x4*)(mp + 4 * F.lane + 256 * j), sc = *(const f32x4*)(mp + D + 4 * F.lane + 256 * j);
                const f32x4 h = (v[j] * rstd * g[j]) * (sc + 1.0f) + sh;
                u32x2 o; o.x = pk2(h.x, h.y); o.y = pk2(h.z, h.w);
                *(u32x2*)(H + (size_t)r * D + 4 * F.lane + 256 * j) = o; }
        } else {
#pragma unroll
            for (int j = 0; j < 4; ++j) *(f32x4*)(xout + 4 * F.lane + 256 * j) = v[j] * rstd * g[j];
        }
    }
}

__device__ __forceinline__ void p3_postproj(Frame& F, int layer) {
    frame_ids(F);
    const int gw = F.vcu * 8 + F.wave, NGW = F.G * 8, l = F.lane;
    bf16_t* P = (bf16_t*)(F.ws + WS_PROJ);
    const float* rope = (const float*)(F.ws + WS_ROPE);
    const float qg = F.in[I_QG][layer * HD + l], kg = F.in[I_KG][layer * HD + l];
    const int f = l & 15, a = l >> 5, t = (l >> 4) & 1;
    for (int r = gw; r < MT; r += NGW) {
        bf16_t* row = P + (size_t)r * DIN;
        const bool lat = r < NLAT; const int s = r & (SEQ - 1);
        const int pos = a == 0 ? (s >> 6) : (s & 63);
        const float cs = rope[pos * 16 + f], sn = rope[1024 + pos * 16 + f];
#pragma unroll
        for (int hh = 0; hh < 16; ++hh) {
            const int col = (hh < 8 ? C_AQ + hh * 64 : (hh < 14 ? C_CQ + (hh - 8) * 64 : C_CK + (hh - 14) * 64)) + l;
            const bool isq = hh < 6 || (hh >= 8 && hh < 14);
            float v = bf2f(row[col]);
            if (hh < 8) { const float ss = wave_sum(v * v); v = v * (1.0f / sqrtf(ss * (1.0f / HD) + EPS)) * (hh < 6 ? qg : kg); }
            if (lat) { const float p = __shfl_xor(v, 16); v = t == 0 ? v * cs - p * sn : v * cs + p * sn; }
            if (isq) v *= QSCALE;
            row[col] = (bf16_t)f2bf(v);
        }
#pragma unroll
        for (int j = 0; j < 4; ++j) { const float av = bf2f(row[C_BU + j * 64 + l]), gv = bf2f(row[C_BG + j * 64 + l]);
            row[C_BU + j * 64 + l] = (bf16_t)f2bf(av / (1.0f + __expf(-gv))); }
    }
}

struct AttnUnit { int qrow0, qpos0, qcol, kcol, vcol, ocol, krow_ctx, krow_band, nband, kpos0, masked, has_sink; float sink2; };
__device__ __forceinline__ int crow(int r, int hi) { return (r & 3) + 8 * (r >> 2) + 4 * hi; }
__device__ __forceinline__ s16x4 vtr(const LAS unsigned char* p) { typedef short v4i16_t __attribute__((ext_vector_type(4))); return __builtin_bit_cast(s16x4, __builtin_amdgcn_ds_read_tr16_b64_v4i16((LAS v4i16_t*)p)); }
constexpr int AT_PITCH = 144, AT_K = 0, AT_V = 64 * AT_PITCH, AT_WS = 2 * 64 * AT_PITCH;
__device__ __forceinline__ void attn_unit_v1(const AttnUnit& u, const bf16_t* proj, bf16_t* mix, LAS unsigned char* lds) {
    int tid = threadIdx.x; asm volatile("" : "+v"(tid));
    const int lane = tid & 63, r32 = lane & 31, hi = lane >> 5; const int wid = __builtin_amdgcn_readfirstlane(tid >> 6);
    LAS unsigned char* Ks = lds + AT_K; LAS unsigned char* Vs = lds + AT_V; LAS float* wsf = (LAS float*)(lds + AT_WS) + wid * 64;
    const bf16_t* qp = proj + (size_t)(u.qrow0 + wid * 32 + r32) * DIN + u.qcol + 8 * hi;
    bf16x8 qf[4];
#pragma unroll
    for (int d0 = 0; d0 < 4; ++d0) qf[d0] = *(const bf16x8*)(qp + 16 * d0);
    float m = -INFINITY, l = 0.f; f32x16 o0 = {}, o1 = {};
    const int srow = tid >> 3, sch = tid & 7;
    const int ntile = 4 + u.nband;
    const int vq = (lane & 15) >> 2, vp = lane & 3, vg = (lane >> 4) & 1;
    const LAS unsigned char* vbase = Vs + (4 * hi + vq) * AT_PITCH + (16 * vg + 4 * vp) * 2;
    for (int t = 0; t < ntile; ++t) {
        const int krow = (t < 4) ? u.krow_ctx + 64 * t : u.krow_band + 64 * (t - 4);
        const bf16_t* src = proj + (size_t)(krow + srow) * DIN + sch * 8;
        const u32x4 kv = *(const u32x4*)(src + u.kcol); const u32x4 vv = *(const u32x4*)(src + u.vcol);
        __syncthreads();
        *(LAS u32x4*)(Ks + srow * AT_PITCH + sch * 16) = kv; *(LAS u32x4*)(Vs + srow * AT_PITCH + sch * 16) = vv;
        __syncthreads();
        f32x16 p0 = {}, p1 = {};
#pragma unroll
        for (int d0 = 0; d0 < 4; ++d0) {
            const bf16x8 a0 = *(const LAS bf16x8*)(Ks + r32 * AT_PITCH + (16 * d0 + 8 * hi) * 2);
            const bf16x8 a1 = *(const LAS bf16x8*)(Ks + (32 + r32) * AT_PITCH + (16 * d0 + 8 * hi) * 2);
            p0 = __builtin_amdgcn_mfma_f32_32x32x16_bf16(a0, qf[d0], p0, 0, 0, 0);
            p1 = __builtin_amdgcn_mfma_f32_32x32x16_bf16(a1, qf[d0], p1, 0, 0, 0);
        }
        if (u.masked && t >= 4) {
            const int qpos = u.qpos0 + wid * 32 + r32, kb = u.kpos0 + 64 * (t - 4) + 4 * hi;
#pragma unroll
            for (int r = 0; r < 16; ++r) { const int dd = kb + (r & 3) + 8 * (r >> 2) - qpos;
                if (dd > 128 || dd < -128) p0[r] = -INFINITY;
                if (dd + 32 > 128 || dd + 32 < -128) p1[r] = -INFINITY; }
        }
        float mx = fmaxf(p0[0], p1[0]);
#pragma unroll
        for (int r = 1; r < 16; ++r) mx = fmaxf(mx, fmaxf(p0[r], p1[r]));
        mx = fmaxf(mx, __shfl_xor(mx, 32));
        const float mn = fmaxf(m, mx);
        const float alpha = __builtin_amdgcn_exp2f(m - mn);
        float ls = 0.f;
#pragma unroll
        for (int r = 0; r < 16; ++r) { p0[r] = __builtin_amdgcn_exp2f(p0[r] - mn); p1[r] = __builtin_amdgcn_exp2f(p1[r] - mn); ls += p0[r] + p1[r]; }
        l = l * alpha + ls; m = mn;
        if (hi == 0) wsf[r32] = alpha;
        LDS_WAIT();
#pragma unroll
        for (int r = 0; r < 16; ++r) { const float a = wsf[crow(r, hi)]; o0[r] *= a; o1[r] *= a; }
        bf16x8 pa[4];
#pragma unroll
        for (int ks = 0; ks < 4; ++ks) {
            u32x4 w;
            if (ks < 2) { const int b = 8 * ks; w.x = pk2(p0[b], p0[b + 1]); w.y = pk2(p0[b + 2], p0[b + 3]); w.z = pk2(p0[b + 4], p0[b + 5]); w.w = pk2(p0[b + 6], p0[b + 7]); }
            else { const int b = 8 * (ks - 2); w.x = pk2(p1[b], p1[b + 1]); w.y = pk2(p1[b + 2], p1[b + 3]); w.z = pk2(p1[b + 4], p1[b + 5]); w.w = pk2(p1[b + 6], p1[b + 7]); }
            pa[ks] = __builtin_bit_cast(bf16x8, w);
        }
#pragma unroll
        for (int ks = 0; ks < 4; ++ks) {
            const int kb = 32 * (ks >> 1) + 16 * (ks & 1);
#pragma unroll
            for (int d0 = 0; d0 < 2; ++d0) {
                const s16x4 lo = vtr(vbase + kb * AT_PITCH + d0 * 64), hh = vtr(vbase + (kb + 8) * AT_PITCH + d0 * 64);
                const bf16x8 vf = {lo[0], lo[1], lo[2], lo[3], hh[0], hh[1], hh[2], hh[3]};
                if (d0 == 0) o0 = __builtin_amdgcn_mfma_f32_32x32x16_bf16(pa[ks], vf, o0, 0, 0, 0);
                else o1 = __builtin_amdgcn_mfma_f32_32x32x16_bf16(pa[ks], vf, o1, 0, 0, 0);
            }
        }
    }
    l += __shfl_xor(l, 32);
    if (u.has_sink) l += __builtin_amdgcn_exp2f(u.sink2 - m);
    LDS_WAIT();
    if (hi == 0) wsf[32 + r32] = l;
    LDS_WAIT();
#pragma unroll
    for (int r = 0; r < 16; ++r) { const int q = crow(r, hi); const float rl = 1.0f / wsf[32 + q];
        bf16_t* op = mix + (size_t)(u.qrow0 + wid * 32 + q) * DMIX + u.ocol + r32;
        op[0] = (bf16_t)f2bf(o0[r] * rl); op[32] = (bf16_t)f2bf(o1[r] * rl); }
    LDS_WAIT();
}
constexpr int CV_H = 0, CV_W = 49152;
__device__ __forceinline__ void conv_unit(Frame& F, int layer, int R0, int L, int t0, const bf16_t* proj, bf16_t* mix) {
    LAS unsigned char* hs = F.lds + CV_H; const LAS float* cw = (const LAS float*)(F.lds + CV_W);
    __syncthreads();
    for (int idx = F.tid; idx < 94 * 32; idx += 512) { const int row = idx >> 5, ch = idx & 31, tp = t0 - 15 + row;
        u32x4 v = {0u, 0u, 0u, 0u};
        if (tp >= 0 && tp < L) v = *(const u32x4*)(proj + (size_t)(R0 + tp) * DIN + C_BU + ch * 8);
        *(LAS u32x4*)(hs + row * 512 + ch * 16) = v; }
    __syncthreads();
    const int c4 = F.lane * 4;
    const f32x4 bias = *(const f32x4*)(F.in[I_CONVB] + layer * BCH + c4), lg = *(const f32x4*)(F.in[I_LNG] + layer * BCH + c4), lb = *(const f32x4*)(F.in[I_LNB] + layer * BCH + c4);
    for (int i = 0; i < 8; ++i) {
        const int tt = F.wave * 8 + i;
        f32x4 acc = bias;
#pragma unroll
        for (int k = 0; k < CONVW; ++k) { const u32x2 xr = *(const LAS u32x2*)(hs + (tt + k) * 512 + F.lane * 8); const f32x4 wv = *(const LAS f32x4*)(cw + k * 256 + c4);
            acc.x += bf2f(xr.x & 0xffffu) * wv.x; acc.y += bf2f(xr.x >> 16) * wv.y; acc.z += bf2f(xr.y & 0xffffu) * wv.z; acc.w += bf2f(xr.y >> 16) * wv.w; }
        const float mean = wave_sum((acc.x + acc.y) + (acc.z + acc.w)) * (1.0f / BCH);
        const f32x4 d = acc - mean;
        const float var = wave_sum((d.x * d.x + d.y * d.y) + (d.z * d.z + d.w * d.w)) * (1.0f / BCH);
        const f32x4 y = d * (1.0f / sqrtf(var + EPS)) * lg + lb;
        f32x4 s; s.x = y.x / (1.0f + __expf(-y.x)); s.y = y.y / (1.0f + __expf(-y.y)); s.z = y.z / (1.0f + __expf(-y.z)); s.w = y.w / (1.0f + __expf(-y.w));
        u32x2 o; o.x = pk2(s.x, s.y); o.y = pk2(s.z, s.w);
        *(u32x2*)(mix + (size_t)(R0 + t0 + tt) * DMIX + O_B + c4) = o;
    }
}
__device__ __forceinline__ void p4_mixers(Frame& F, int layer) {
    frame_ids(F);
    const bf16_t* proj = (const bf16_t*)(F.ws + WS_PROJ); bf16_t* mix = (bf16_t*)(F.ws + WS_H);
    const bool with_ctx = layer < DEPTH - 1;
    const int n_att = 3072 + (with_ctx ? 384 : 0);
    for (int un = F.vcu; un < n_att; un += F.G) {
        AttnUnit u; int kind, idx;
        if (un < 1536) { kind = 0; idx = un; } else if (un < 3072) { kind = 1; idx = un - 1536; } else if (un < 3264) { kind = 2; idx = un - 3072; } else { kind = 3; idx = un - 3264; }
        const bool isC = kind & 1, isctx = kind >= 2;
        int b, h, qb;
        if (!isctx) { qb = idx & 7; h = (idx >> 3) % 6; b = idx / 48; } else { qb = 0; h = idx % 6; b = idx / 6; }
        const int kvh = h / 3;
        u.qcol = (isC ? C_CQ : C_AQ) + h * 64; u.kcol = (isC ? C_CK : C_AK) + kvh * 64; u.vcol = (isC ? C_CV : C_AV) + kvh * 64; u.ocol = (isC ? O_C : O_A) + h * 64;
        u.krow_ctx = NLAT + b * CTXL;
        u.has_sink = isC; u.sink2 = isC ? F.in[I_SINK][layer * 6 + h] * LOG2E : 0.f;
        if (isctx) { u.qrow0 = NLAT + b * CTXL; u.qpos0 = 0; u.nband = 0; u.krow_band = 0; u.kpos0 = 0; u.masked = 0; }
        else {
            u.qrow0 = b * SEQ + qb * 256; u.qpos0 = qb * 256;
            if (isC) { const int ks = qb * 256 - 128 < 0 ? 0 : qb * 256 - 128, ke = qb * 256 + 384 > SEQ ? SEQ : qb * 256 + 384;
                u.kpos0 = ks; u.nband = (ke - ks) >> 6; u.krow_band = b * SEQ + ks; u.masked = 1; }
            else { u.kpos0 = 0; u.nband = SEQ / 64; u.krow_band = b * SEQ; u.masked = 0; }
        }
        attn_unit_v1(u, proj, mix, F.lds);
    }
    __syncthreads();
    { LAS float* cw = (LAS float*)(F.lds + CV_W);
      for (int idx = F.tid; idx < CONVW * BCH; idx += 512) cw[idx] = F.in[I_CONVW][layer * CONVW * BCH + idx]; }
    const int n_conv = 1024 + (with_ctx ? 128 : 0);
    for (int un = F.vcu; un < n_conv; un += F.G) {
        if (un < 1024) conv_unit(F, layer, (un >> 5) * SEQ, SEQ, (un & 31) * 64, proj, mix);
        else conv_unit(F, layer, NLAT + ((un - 1024) >> 2) * CTXL, CTXL, ((un - 1024) & 3) * 64, proj, mix);
    }
    __syncthreads();
}

__device__ __forceinline__ void p6_router(Frame& F, int layer, int nrows) {
    frame_ids(F);
    LAS float* Wt = (LAS float*)F.lds;
    LAS unsigned* rec = (LAS unsigned*)(F.lds + LDS_REC);
    LAS unsigned* hist = (LAS unsigned*)(F.lds + LDS_MISC) + 64; LAS unsigned* base = (LAS unsigned*)(F.lds + LDS_MISC) + 96;
    const float* wg = F.in[I_WGRP] + (size_t)layer * D * 4; const float* we = F.in[I_WEXP] + (size_t)layer * D * NE;
    for (int idx = F.tid; idx < 36 * 1024; idx += 512) { const int j = idx >> 10, k = idx & 1023; Wt[idx] = j < 4 ? wg[k * 4 + j] : we[k * NE + (j - 4)]; }
    if (F.tid < NE) hist[F.tid] = 0u;
    __syncthreads();
    const int rpb = (nrows + F.G - 1) / F.G, rbeg = F.vcu * rpb, rend = rbeg + rpb < nrows ? rbeg + rpb : nrows;
    const float* mod = (const float*)(F.ws + WS_MOD); bf16_t* H = (bf16_t*)(F.ws + WS_H);
    f32x4 g[4];
#pragma unroll
    for (int j = 0; j < 4; ++j) g[j] = *(const f32x4*)(F.in[I_N2G] + layer * D + 4 * F.lane + 256 * j);
    const float* bgp = F.in[I_BGRP] + layer * 4; const float* bep = F.in[I_BEXP] + layer * NE;
    for (int r0 = rbeg + 2 * F.wave; r0 < rend; r0 += 16) {
        f32x4 h[2][4];
#pragma unroll
        for (int q = 0; q < 2; ++q) {
            const int r = (r0 + q < rend) ? r0 + q : r0;
            const bool lat = r < NLAT; const int mrow = lat ? r / SEQ : BATCH;
            const float* xin = lat ? F.out + (size_t)r * D : (const float*)(F.ws + WS_XC) + (size_t)(r - NLAT) * D;
            f32x4 v[4]; float ss = 0.f;
#pragma unroll
            for (int j = 0; j < 4; ++j) { v[j] = *(const f32x4*)(xin + 4 * F.lane + 256 * j); ss += (v[j].x * v[j].x + v[j].y * v[j].y) + (v[j].z * v[j].z + v[j].w * v[j].w); }
            const float rstd = 1.0f / sqrtf(wave_sum(ss) * (1.0f / D) + EPS);
            const float* mp = mod + ((size_t)layer * 33 + mrow) * (NMOD * D) + 3 * D;
#pragma unroll
            for (int j = 0; j < 4; ++j) { const f32x4 sh = *(const f32x4*)(mp + 4 * F.lane + 256 * j), sc = *(const f32x4*)(mp + D + 4 * F.lane + 256 * j);
                h[q][j] = (v[j] * rstd * g[j]) * (sc + 1.0f) + sh;
                u32x2 o; o.x = pk2(h[q][j].x, h[q][j].y); o.y = pk2(h[q][j].z, h[q][j].w);
                if (q == 0 || r0 + 1 < rend) *(u32x2*)(H + (size_t)r * D + 4 * F.lane + 256 * j) = o; }
        }
        float ev[64], gv[8];
#pragma unroll
        for (int jj = 0; jj < 36; ++jj) {
            float a0 = 0.f, a1 = 0.f;
#pragma unroll
            for (int j = 0; j < 4; ++j) { const f32x4 w = *(const LAS f32x4*)(Wt + jj * 1024 + 4 * F.lane + 256 * j);
                a0 += (h[0][j].x * w.x + h[0][j].y * w.y) + (h[0][j].z * w.z + h[0][j].w * w.w);
                a1 += (h[1][j].x * w.x + h[1][j].y * w.y) + (h[1][j].z * w.z + h[1][j].w * w.w); }
            if (jj < 4) { gv[jj] = a0; gv[4 + jj] = a1; } else { ev[jj - 4] = a0; ev[32 + jj - 4] = a1; }
        }
#pragma unroll
        for (int s = 32, n = 64; s >= 1; s >>= 1, n >>= 1) {
            const bool up = (F.lane & s) != 0;
#pragma unroll
            for (int i = 0; i < n / 2; ++i) { const float keep = up ? ev[i + n / 2] : ev[i], send = up ? ev[i] : ev[i + n / 2]; ev[i] = keep + __shfl_xor(send, s); }
        }
#pragma unroll
        for (int s = 32, n = 8; s >= 8; s >>= 1, n >>= 1) {
            const bool up = (F.lane & s) != 0;
#pragma unroll
            for (int i = 0; i < n / 2; ++i) { const float keep = up ? gv[i + n / 2] : gv[i], send = up ? gv[i] : gv[i + n / 2]; gv[i] = keep + __shfl_xor(send, s); }
        }
        gv[0] += __shfl_xor(gv[0], 4); gv[0] += __shfl_xor(gv[0], 2); gv[0] += __shfl_xor(gv[0], 1);
        const float etot = ev[0], gtot = gv[0];
#pragma unroll
        for (int q = 0; q < 2; ++q) {
            if (q == 1 && r0 + 1 >= rend) break;
            float gl[4];
#pragma unroll
            for (int gi = 0; gi < 4; ++gi) gl[gi] = __shfl(gtot, (q * 4 + gi) * 8) + bgp[gi];
            int gidx = 0; float gmax = gl[0];
#pragma unroll
            for (int gi = 1; gi < 4; ++gi) if (gl[gi] > gmax) { gmax = gl[gi]; gidx = gi; }
            float gsum = 0.f;
#pragma unroll
            for (int gi = 0; gi < 4; ++gi) gsum += __expf(gl[gi] - gmax);
            const float gval = 1.0f / gsum;
            float el[8];
#pragma unroll
            for (int j = 0; j < 8; ++j) el[j] = __shfl(etot, q * 32 + gidx * 8 + j) + bep[gidx * 8 + j];
            int i0 = 0; float v0 = el[0];
#pragma unroll
            for (int j = 1; j < 8; ++j) if (el[j] > v0) { v0 = el[j]; i0 = j; }
            int i1 = -1; float v1 = -INFINITY;
#pragma unroll
            for (int j = 0; j < 8; ++j) if (j != i0 && el[j] > v1) { v1 = el[j]; i1 = j; }
            const float t = __expf(v1 - v0), w0 = gval / (1.0f + t), w1 = gval * t / (1.0f + t);
            if (F.lane == 0) {
                const int e0 = gidx * 8 + i0, e1 = gidx * 8 + i1;
                const unsigned x0 = atomicAdd((unsigned*)&hist[e0], 1u), x1 = atomicAdd((unsigned*)&hist[e1], 1u);
                LAS unsigned* rp = rec + (size_t)(r0 + q - rbeg) * 4;
                rp[0] = (unsigned)e0 | (x0 << 8); rp[1] = (unsigned)e1 | (x1 << 8); rp[2] = __float_as_uint(w0); rp[3] = __float_as_uint(w1);
            }
        }
    }
    __syncthreads();
    unsigned* cnt = (unsigned*)(F.ws + WS_CTL) + CW_CNT + layer * NE;
    if (F.tid < NE) base[F.tid] = hist[F.tid] ? atomicAdd(&cnt[F.tid], hist[F.tid]) : 0u;
    __syncthreads();
    int* tok = (int*)(F.ws + WS_TOK); u32x4* slot = (u32x4*)(F.ws + WS_SLOT);
    for (int i = F.tid; i < rend - rbeg; i += 512) {
        const LAS unsigned* rp = rec + (size_t)i * 4; const unsigned a = rp[0], b = rp[1];
        const unsigned e0 = a & 0xffu, e1 = b & 0xffu, p0 = base[e0] + (a >> 8), p1 = base[e1] + (b >> 8);
        tok[(size_t)e0 * TOKCAP + p0] = rbeg + i; tok[(size_t)e1 * TOKCAP + p1] = rbeg + i;
        u32x4 s; s.x = (e0 << 20) | p0; s.y = (e1 << 20) | p1; s.z = rp[2]; s.w = rp[3];
        slot[rbeg + i] = s;
    }
    __syncthreads();
}

__global__ void __launch_bounds__(512, 2) hymba_fwd(Args args) {
    extern __shared__ __attribute__((aligned(16))) unsigned char lds_raw[];
    Frame F;
    F.lds = (LAS unsigned char*)lds_raw;
    F.tid = threadIdx.x; F.lane = F.tid & 63; F.wave = __builtin_amdgcn_readfirstlane(F.tid >> 6);
    F.G = gridDim.x; { const int bx = blockIdx.x; F.vcu = (F.G % 8 == 0) ? (bx % 8) * (F.G / 8) + bx / 8 : bx; }
    F.in = args.in; F.out = args.out; F.ws = args.ws;
    for (int u = F.tid; u < 256; u += 512) ((LAS unsigned*)(F.lds + LDS_MISC))[u] = 0u;
    __syncthreads();
    const int lo = args.ph_lo, hi = args.ph_hi;
    XcdBarrier bar; bar.bar = (unsigned*)(F.ws + WS_CTL) + CW_BAR; bar.x = 0; bar.st = nullptr;
    if (hi - lo > 1) bar = xcd_barrier_post((unsigned*)(F.ws + WS_CTL) + CW_BAR, (volatile LAS unsigned*)(F.lds + LDS_MISC));
#ifndef ONLY_PH
#define ONLY_PH -1
#endif
#define IN(k) (lo <= (k) && (k) < hi)
#ifndef SKIP_MASK
#define SKIP_MASK 0
#endif
#define INL(j) ((ONLY_PH < 0 || ONLY_PH == 1 + (j)) && !((SKIP_MASK >> (1 + (j))) & 1) && IN(g0 + (j)))
#define SEAM(k) do { if ((k) + 1 < hi) xcd_barrier(bar); } while (0)
    bf16_t* const Hb = (bf16_t*)(F.ws + WS_H); bf16_t* const Pb = (bf16_t*)(F.ws + WS_PROJ); bf16_t* const Ab = (bf16_t*)(F.ws + WS_ACT);
    float* const XC = (float*)(F.ws + WS_XC); const float* const modp = (const float*)(F.ws + WS_MOD);
    const LAS int* tstart = (const LAS int*)(F.lds + LDS_MISC) + 16;

    if ((ONLY_PH < 0 || ONLY_PH == 0) && !(SKIP_MASK & 1) && IN(0)) { p0_prologue(F); SEAM(0); }
#pragma unroll 1
    for (int layer = 0; layer < DEPTH; ++layer) {
        const int g0 = 1 + NPH_LAYER * layer;
        const bool with_ctx = layer < DEPTH - 1;
        const int nrows = with_ctx ? MT : NLAT;
        if (INL(0)) { p_norm<0>(F, layer, layer - 1, MT); SEAM(g0 + 0); }
        if (INL(1)) {
            pg8::DenseOrder S; S.init(Hb, (const bf16_t*)(F.ws + WS_WIN) + (size_t)layer * DIN * D, MT, DIN, D, F.G, (int)blockIdx.x);
            pg8::EpiBf16 E{Pb, DIN};
            pg8::gemm_phase<pg8::EpiBf16, pg8::DenseOrder, false, true>(F.lds, D, S, E);
            SEAM(g0 + 1);
        }
        if (INL(2)) { p3_postproj(F, layer); SEAM(g0 + 2); }
        if (INL(3)) { p4_mixers(F, layer); SEAM(g0 + 3); }
        if (INL(4)) {
            pg8::DenseOrder S; S.init(Hb, (const bf16_t*)(F.ws + WS_WOUT) + (size_t)layer * D * DMIX, nrows, D, DMIX, F.G, (int)blockIdx.x);
            pg8::EpiResid E{layer == 0 ? F.in[I_X] : F.out, layer == 0 ? F.in[I_CTX] : XC, F.out, XC, modp + (size_t)layer * 33 * (NMOD * D) + 2 * D};
            pg8::gemm_phase<pg8::EpiResid, pg8::DenseOrder, false, true>(F.lds, DMIX, S, E);
            SEAM(g0 + 4);
        }
        if (INL(5)) { p6_router(F, layer, nrows); SEAM(g0 + 5); }
        if (INL(6)) {
            build_tstart(F, layer);
            pg8::MoeOrder S{Hb, (const bf16_t*)(F.ws + WS_WGU) + (size_t)layer * NE * 1024 * 1024, (size_t)1024 * 1024, D, 4, tstart, F.G, (int)blockIdx.x,
                            (const int*)(F.ws + WS_TOK), (const int*)((const unsigned*)(F.ws + WS_CTL) + CW_CNT + layer * NE)};
            pg8::EpiGlu E{Ab};
            pg8::gemm_phase<pg8::EpiGlu, pg8::MoeOrder, true, true>(F.lds, D, S, E);
            SEAM(g0 + 6);
        }
        if (INL(7)) {
            build_tstart(F, layer);
            pg8::MoeOrder S{Ab, (const bf16_t*)(F.ws + WS_WD) + (size_t)layer * NE * 1024 * DE, (size_t)1024 * DE, DE, 4, tstart, F.G, (int)blockIdx.x, nullptr, nullptr};
            pg8::EpiBf16 E{Pb, D};
            pg8::gemm_phase<pg8::EpiBf16, pg8::MoeOrder, false, true>(F.lds, DE, S, E);
            SEAM(g0 + 7);
        }
    }
    if ((ONLY_PH < 0 || ONLY_PH == 9) && !((SKIP_MASK >> 9) & 1) && IN(PH_FINAL)) { p_norm<1>(F, 0, DEPTH - 1, NLAT); }
#undef IN
#undef INL
#undef SEAM
}

extern "C" void kernel_launch(void* const* d_in, const int* in_sizes, int n_in, void* d_out, int out_size, void* d_ws, size_t ws_size, hipStream_t stream) {
    static int grid = 0;
    if (grid == 0) {
        if (n_in != N_IN || out_size != NLAT * D || ws_size < WS_END) { fprintf(stderr, "kernel_launch: unexpected shapes (n_in %d out %d ws %zu); nothing launched\n", n_in, out_size, ws_size); grid = -1; return; }
        int dev = 0, cus = 0;
        if (hipGetDevice(&dev) != hipSuccess || hipDeviceGetAttribute(&cus, hipDeviceAttributeMultiprocessorCount, dev) != hipSuccess) { grid = -1; return; }
        if (hipFuncSetAttribute((const void*)hymba_fwd, hipFuncAttributeMaxDynamicSharedMemorySize, LDS_BYTES) != hipSuccess) { fprintf(stderr, "kernel_launch: hipFuncSetAttribute failed\n"); grid = -1; return; }
        int per_cu = 0;
        if (hipOccupancyMaxActiveBlocksPerMultiprocessor(&per_cu, (const void*)hymba_fwd, 512, LDS_BYTES) != hipSuccess || per_cu < 1) { fprintf(stderr, "kernel_launch: occupancy query says %d\n", per_cu); }
        (void)hipGetLastError();
        grid = cus;
    }
    if (grid < 0) return;
    (void)hipMemsetAsync((char*)d_ws + WS_CTL, 0, CTL_ZERO_BYTES, stream);
    Args a{};
    for (int i = 0; i < N_IN; ++i) a.in[i] = (const float*)d_in[i];
    a.out = (float*)d_out; a.ws = (unsigned char*)d_ws;
#if MK_ONE_LAUNCH
    a.ph_lo = 0; a.ph_hi = NPHASES;
    hipLaunchKernelGGL(hymba_fwd, dim3(grid), dim3(512), LDS_BYTES, stream, a);
#else
    for (int p = 0; p < NPHASES; ++p) { a.ph_lo = p; a.ph_hi = p + 1; hipLaunchKernelGGL(hymba_fwd, dim3(grid), dim3(512), LDS_BYTES, stream, a); }
#endif
}
```

```cpp
#include <hip/hip_runtime.h>
#include <cstdint>
#include <cstdio>

#ifndef REP_MASK
#define REP_MASK 0
#endif
#ifndef MK_ONE_LAUNCH
#define MK_ONE_LAUNCH 1
#endif

#define LAS __attribute__((address_space(3)))
#define GAS __attribute__((address_space(1)))
typedef unsigned short bf16_t;
typedef short bf16x8 __attribute__((ext_vector_type(8)));
typedef short s16x4 __attribute__((ext_vector_type(4)));
typedef float f32x4 __attribute__((ext_vector_type(4)));
typedef float f32x2 __attribute__((ext_vector_type(2)));
typedef float f32x16 __attribute__((ext_vector_type(16)));
typedef unsigned u32x4 __attribute__((ext_vector_type(4)));
typedef unsigned u32x2 __attribute__((ext_vector_type(2)));

constexpr int D = 1024, BATCH = 32, SEQ = 2048, DEPTH = 4, CTXL = 256, HD = 64;
constexpr int NLAT = BATCH * SEQ, NCTX = BATCH * CTXL, MT = NLAT + NCTX;
constexpr int DIN = 1792, DMIX = 1024, NMOD = 6;
constexpr int PP = 1536;
constexpr int C_AQ = 0, C_AK = 384, C_CQ = 512, C_CK = 896, C_AV = 1024, C_CV = 1152, C_BU = 1280;
constexpr int O_A = 0, O_B = 384, O_C = 640;
constexpr int NE = 32, DE = 512, CONVW = 31, BCH = 256;
constexpr int TOKCAP = MT;
constexpr int NP_MAX = (2 * MT / 256 + NE) * 256;
constexpr float EPS = 1e-6f;
constexpr float LOG2E = 1.4426950408889634f;
constexpr float QSCALE = 0.125f * LOG2E;

constexpr size_t MiB = 1u << 20;
constexpr size_t WS_CTL = 0, CTL_ZERO_BYTES = 1 * MiB;
constexpr size_t WS_ROPE = 1 * MiB;
constexpr size_t WS_MOD = 2 * MiB;
constexpr size_t WS_WIN = 6 * MiB;
constexpr size_t WS_WOUT = 20 * MiB;
constexpr size_t WS_WGU = 28 * MiB;
constexpr size_t WS_WD = 284 * MiB;
constexpr size_t WS_XC = 412 * MiB;
constexpr size_t WS_H = 444 * MiB;
constexpr size_t WS_PROJ = 588 * MiB;
constexpr size_t WS_ACT = 892 * MiB;
constexpr size_t WS_TOK = 1044 * MiB;
constexpr size_t WS_SLOT = 1053 * MiB;
constexpr size_t WS_END = 1055 * MiB;
constexpr int CW_BAR = 4096;
constexpr int CW_CNT = 16384;

constexpr int LDS_BYTES = 155648;
constexpr int LDS_REC = 147456;
constexpr int LDS_MISC = 154624;

__device__ __forceinline__ float bf2f(unsigned b) { return __uint_as_float(b << 16); }
__device__ __forceinline__ unsigned f2bf(float f) { unsigned u = __float_as_uint(f); return (u + 0x7fffu + ((u >> 16) & 1u)) >> 16; }
__device__ __forceinline__ unsigned pk2(float lo, float hi) { return f2bf(lo) | (f2bf(hi) << 16); }
__device__ __forceinline__ float wave_sum(float v) {
#pragma unroll
    for (int o = 32; o >= 1; o >>= 1) v += __shfl_xor(v, o);
    return v;
}
#define LDS_WAIT() asm volatile("s_waitcnt lgkmcnt(0)" ::: "memory")
#define VM_WAIT() asm volatile("s_waitcnt vmcnt(0)" ::: "memory")

namespace pg8 {
constexpr int BM = 256, BK = 64, HALF = 128, HTB = HALF * BK * 2, STAGE_BYTES = 8 * HTB, NXCD = 8, WGM = 8;
__host__ __device__ __forceinline__ int lds_byte(int r, int c) { const int st = (r >> 4) * 2 + (c >> 5), rr = r & 15, cc = c & 31, ob = rr * 64 + cc * 2; return st * 1024 + (ob ^ (((ob >> 9) & 1) << 5)); }
__host__ __device__ __forceinline__ void stage_rc(int b, int& R, int& C) { const int st = b / 1024, sb = b % 1024, swz = sb ^ (((sb >> 9) & 1) << 5); R = (st >> 1) * 16 + swz / 64; C = (st & 1) * 32 + (swz % 64) / 2; }
__host__ __device__ __forceinline__ int perm32(int rho) { const int n = rho >> 4, i = rho & 15; return 8 * (i >> 2) + 4 * n + (i & 3); }

struct Unit { int pm, pn, e; };

struct DenseOrder {
    const bf16_t* A; const bf16_t* Bt; int K; int nM, nN, nwg, G, c;
    __device__ void init(const bf16_t* A_, const bf16_t* Bt_, int M, int N, int K_, int G_, int c_) { A = A_; Bt = Bt_; K = K_; nM = M / BM; nN = N / BM; nwg = nM * nN; G = G_; c = c_; }
    __device__ __forceinline__ bool next(int i, Unit& u) const {
        const long L = (long)i * G + c; if (L >= nwg) return false;
        int wgid = (int)L; { const int q = nwg / NXCD, r = nwg % NXCD, xcd = wgid % NXCD, off = wgid / NXCD; wgid = (xcd < r ? xcd * (q + 1) : r * (q + 1) + (xcd - r) * q) + off; }
        const int nig = WGM * nN, gid = wgid / nig, fm = gid * WGM, gsz = (nM - fm) < WGM ? (nM - fm) : WGM;
        u.pm = fm + ((wgid % nig) % gsz); u.pn = (wgid % nig) / gsz; u.e = 0; return true;
    }
    __device__ __forceinline__ const char* a_base(const Unit& u) const { return (const char*)A + (size_t)u.pm * BM * K * 2; }
    __device__ __forceinline__ const char* b_base(const Unit& u) const { return (const char*)Bt + (size_t)u.pn * BM * K * 2; }
    __device__ __forceinline__ unsigned row_off(const Unit&, int) const { return 0u; }
};
struct MoeOrder {
    const bf16_t* A; const bf16_t* W; size_t wstride; int K; int ncol; const LAS int* tstart; int G, c;
    const int* tok; const int* cnt;
    __device__ __forceinline__ bool next(int i, Unit& u) const {
        const long L = (long)i * G + c; const int nt = tstart[NE];
        if (L >= (long)nt * ncol) return false;
        u.pm = (int)(L / ncol); u.pn = (int)(L % ncol);
        int e = 0;
#pragma unroll 1
        for (; e < NE - 1; ++e) if (tstart[e + 1] > u.pm) break;
        u.e = e; return true;
    }
    __device__ __forceinline__ const char* a_base(const Unit& u) const { return (const char*)A + (tok ? (size_t)0 : (size_t)u.pm * BM * K * 2); }
    __device__ __forceinline__ const char* b_base(const Unit& u) const { return (const char*)W + ((size_t)u.e * wstride + (size_t)u.pn * BM * K) * 2; }
    __device__ __forceinline__ unsigned row_off(const Unit& u, int r) const {
        const int n = cnt[u.e]; int p = (u.pm - tstart[u.e]) * BM + r; p = p < n ? p : n - 1;
        return (unsigned)tok[(size_t)u.e * TOKCAP + p] * (unsigned)(K * 2);
    }
};

__device__ __forceinline__ unsigned cvt_pk_bf16(float lo, float hi) { unsigned r; asm volatile("v_cvt_pk_bf16_f32 %0, %1, %2" : "=v"(r) : "v"(lo), "v"(hi)); return r; }

struct EpiBf16 {
    static constexpr bool PERM = true;
    bf16_t* O; int ldc;
    __device__ __forceinline__ void operator()(const f32x4 (&acc)[2][2][4][2], const Unit& u, int wr, int wc, int fr, int fq) const {
        const int row0 = u.pm * BM + wr * 64 + fr, col0 = u.pn * BM + wc * 32 + 8 * fq;
#pragma unroll
        for (int ai = 0; ai < 2; ++ai)
#pragma unroll
            for (int m = 0; m < 4; ++m) { bf16_t* rowp = O + (size_t)(row0 + ai * HALF + m * 16) * ldc + col0;
#pragma unroll
                for (int bj = 0; bj < 2; ++bj) { const f32x4 v0 = acc[ai][bj][m][0], v1 = acc[ai][bj][m][1];
                    u32x4 w; w.x = cvt_pk_bf16(v0[0], v0[1]); w.y = cvt_pk_bf16(v0[2], v0[3]); w.z = cvt_pk_bf16(v1[0], v1[1]); w.w = cvt_pk_bf16(v1[2], v1[3]);
                    *(u32x4*)(rowp + bj * HALF) = w; } }
    }
};
struct EpiProj {
    static constexpr bool PERM = true;
    bf16_t* O; const float* rope; const float* qg; const float* kg;
    __device__ __forceinline__ void operator()(const f32x4 (&acc)[2][2][4][2], const Unit& u, int wr, int wc, int fr, int fq) const {
        const int row0 = u.pm * BM + wr * 64 + fr;
        if (u.pn == 4) {
            const int col0 = C_AV + wc * 32 + 8 * fq;
#pragma unroll
            for (int ai = 0; ai < 2; ++ai)
#pragma unroll
                for (int m = 0; m < 4; ++m) { bf16_t* rowp = O + (size_t)(row0 + ai * HALF + m * 16) * PP + col0;
#pragma unroll
                    for (int bj = 0; bj < 2; ++bj) { const f32x4 v0 = acc[ai][bj][m][0], v1 = acc[ai][bj][m][1];
                        u32x4 w; w.x = cvt_pk_bf16(v0[0], v0[1]); w.y = cvt_pk_bf16(v0[2], v0[3]); w.z = cvt_pk_bf16(v1[0], v1[1]); w.w = cvt_pk_bf16(v1[2], v1[3]);
                        *(u32x4*)(rowp + bj * HALF) = w; } }
        } else if (u.pn >= 5) {
            const int col0 = C_BU + (u.pn - 5) * HALF + wc * 32 + 8 * fq;
#pragma unroll
            for (int ai = 0; ai < 2; ++ai)
#pragma unroll
                for (int m = 0; m < 4; ++m) { bf16_t* rowp = O + (size_t)(row0 + ai * HALF + m * 16) * PP + col0;
                    float r[8];
#pragma unroll
                    for (int n = 0; n < 2; ++n)
#pragma unroll
                        for (int i = 0; i < 4; ++i) { const float a = acc[ai][0][m][n][i], g = acc[ai][1][m][n][i];
                            r[n * 4 + i] = a * __builtin_amdgcn_rcpf(1.0f + __builtin_amdgcn_exp2f(-g * LOG2E)); }
                    u32x4 w; w.x = cvt_pk_bf16(r[0], r[1]); w.y = cvt_pk_bf16(r[2], r[3]); w.z = cvt_pk_bf16(r[4], r[5]); w.w = cvt_pk_bf16(r[6], r[7]);
                    *(u32x4*)rowp = w; }
        } else {
            const bool isA = u.pn < 2, isq = ((u.pn & 1) == 0) || (wc < 2), lat = u.pm < NLAT / BM;
            const float* gp = isq ? qg : kg;
            f32x4 gn[2][2];
#pragma unroll
            for (int a = 0; a < 2; ++a)
#pragma unroll
                for (int t = 0; t < 2; ++t) gn[a][t] = *(const f32x4*)(gp + 32 * a + 16 * t + 4 * fq);
            const float qs = isq ? QSCALE : 1.0f;
            const int col0 = u.pn * BM + wc * 64 + 8 * fq;
#pragma unroll
            for (int ai = 0; ai < 2; ++ai)
#pragma unroll
                for (int m = 0; m < 4; ++m) {
                    const int row = row0 + ai * HALF + m * 16;
                    f32x4 v[2][2];
#pragma unroll
                    for (int a = 0; a < 2; ++a)
#pragma unroll
                        for (int t = 0; t < 2; ++t) v[a][t] = acc[ai][a][m][t];
                    if (isA) {
                        float ss = 0.f;
#pragma unroll
                        for (int a = 0; a < 2; ++a)
#pragma unroll
                            for (int t = 0; t < 2; ++t) ss += (v[a][t][0] * v[a][t][0] + v[a][t][1] * v[a][t][1]) + (v[a][t][2] * v[a][t][2] + v[a][t][3] * v[a][t][3]);
                        ss += __shfl_xor(ss, 16); ss += __shfl_xor(ss, 32);
                        const float rstd = 1.0f / sqrtf(ss * (1.0f / HD) + EPS);
#pragma unroll
                        for (int a = 0; a < 2; ++a)
#pragma unroll
                            for (int t = 0; t < 2; ++t) v[a][t] = v[a][t] * rstd * gn[a][t];
                    }
                    if (lat) {
                        const int s = row & (SEQ - 1);
#pragma unroll
                        for (int a = 0; a < 2; ++a) { const int pos = a == 0 ? (s >> 6) : (s & 63);
                            const f32x4 cs = *(const f32x4*)(rope + pos * 16 + 4 * fq), sn = *(const f32x4*)(rope + 1024 + pos * 16 + 4 * fq);
                            const f32x4 x1 = v[a][0], x2 = v[a][1];
                            v[a][0] = x1 * cs - x2 * sn; v[a][1] = x2 * cs + x1 * sn; }
                    }
                    bf16_t* rowp = O + (size_t)row * PP + col0;
#pragma unroll
                    for (int a = 0; a < 2; ++a) { const f32x4 p = v[a][0] * qs, q = v[a][1] * qs;
                        u32x4 w; w.x = cvt_pk_bf16(p[0], p[1]); w.y = cvt_pk_bf16(p[2], p[3]); w.z = cvt_pk_bf16(q[0], q[1]); w.w = cvt_pk_bf16(q[2], q[3]);
                        *(u32x4*)(rowp + 32 * a) = w; }
                }
        }
    }
};
struct EpiGlu {
    static constexpr bool PERM = true;
    bf16_t* O;
    __device__ __forceinline__ void operator()(const f32x4 (&acc)[2][2][4][2], const Unit& u, int wr, int wc, int fr, int fq) const {
        const int row0 = u.pm * BM + wr * 64 + fr, col0 = u.pn * HALF + wc * 32 + 8 * fq;
#pragma unroll
        for (int ai = 0; ai < 2; ++ai)
#pragma unroll
            for (int m = 0; m < 4; ++m) { bf16_t* rowp = O + (size_t)(row0 + ai * HALF + m * 16) * DE + col0;
                float r[8];
#pragma unroll
                for (int n = 0; n < 2; ++n)
#pragma unroll
                    for (int i = 0; i < 4; ++i) { const float g = acc[ai][0][m][n][i], up = acc[ai][1][m][n][i];
                        r[n * 4 + i] = g * __builtin_amdgcn_rcpf(1.0f + __builtin_amdgcn_exp2f(-g * LOG2E)) * up; }
                u32x4 w; w.x = cvt_pk_bf16(r[0], r[1]); w.y = cvt_pk_bf16(r[2], r[3]); w.z = cvt_pk_bf16(r[4], r[5]); w.w = cvt_pk_bf16(r[6], r[7]);
                *(u32x4*)rowp = w; }
    }
};
struct EpiResid {
    static constexpr bool PERM = false;
    const float* xin_lat; const float* xin_ctx; float* xout_lat; float* xout_ctx; const float* gate;
    __device__ __forceinline__ void operator()(const f32x4 (&acc)[2][2][4][2], const Unit& u, int wr, int wc, int fr, int fq) const {
        const int col0 = u.pn * BM + wc * 32 + 4 * fq;
        const bool lat = u.pm < NLAT / BM;
        const int mrow = lat ? (u.pm >> 3) : BATCH;
        const size_t rbase = lat ? (size_t)u.pm * BM : (size_t)u.pm * BM - NLAT;
        const float* xin = lat ? xin_lat : xin_ctx; float* xout = lat ? xout_lat : xout_ctx;
        f32x4 gv[2][2];
#pragma unroll
        for (int bj = 0; bj < 2; ++bj)
#pragma unroll
            for (int n = 0; n < 2; ++n) gv[bj][n] = *(const f32x4*)(gate + (size_t)mrow * (NMOD * D) + col0 + bj * HALF + n * 16);
#pragma unroll
        for (int ai = 0; ai < 2; ++ai)
#pragma unroll
            for (int m = 0; m < 4; ++m) { const size_t off = (rbase + ai * HALF + wr * 64 + m * 16 + fr) * D + col0;
#pragma unroll
                for (int bj = 0; bj < 2; ++bj)
#pragma unroll
                    for (int n = 0; n < 2; ++n) { const f32x4 xi = *(const f32x4*)(xin + off + bj * HALF + n * 16);
                        *(f32x4*)(xout + off + bj * HALF + n * 16) = xi + gv[bj][n] * acc[ai][bj][m][n]; } }
    }
};

template <class Epi, class Sched, bool GATHER, bool ALIGN_EPI>
__device__ __forceinline__ void gemm_phase(LAS unsigned char* lds, const int K, const Sched& S, const Epi& E) {
    int tid = threadIdx.x; asm volatile("" : "+v"(tid));
    const int wid = __builtin_amdgcn_readfirstlane(tid >> 6), lane = tid & 63, wr = wid >> 2, wc = wid & 3, fr = lane & 15, fq = lane >> 4;
    const int nt = K / BK;
    unsigned voffA[2], voffB[2]; int sR[2], sC2[2];
#pragma unroll
    for (int i = 0; i < 2; ++i) { int R, C; stage_rc(tid * 16 + i * 8192, R, C); const int Rb = Epi::PERM ? ((R & ~31) + perm32(R & 31)) : R;
        voffA[i] = (unsigned)(R * K + C) * 2u; voffB[i] = (unsigned)(Rb * K + C) * 2u; sR[i] = R; sC2[i] = C * 2; }
    const size_t kstep = (size_t)(BK * 2);
    const size_t hstep = (size_t)HALF * K * 2;
    const unsigned ldsw = (unsigned)wid * 1024u;
    const int aoff = lds_byte(wr * 64 + fr, fq * 8), boff = lds_byte(wc * 32 + fr, fq * 8);
#define PG8_SA(b, h) (((b) * 2 + (h)) * HTB)
#define PG8_SB(b, h) ((4 + (b) * 2 + (h)) * HTB)
#define PG8_STAGE(bufoff, gbase, voff) do { _Pragma("unroll") for (int _i = 0; _i < 2; ++_i) \
        __builtin_amdgcn_global_load_lds((const unsigned*)((const char*)(gbase) + (voff)[_i]), (LAS unsigned*)(lds + (bufoff) + ldsw + _i * 8192), 16, 0, 0); } while (0)
#define PG8_STAGE_A(bufoff, kp, h, O0, O1) do { if constexpr (GATHER) { if ((h) == 0) PG8_STAGE(bufoff, kp, O0); else PG8_STAGE(bufoff, kp, O1); } else { PG8_STAGE(bufoff, (kp) + (h) * hstep, voffA); } } while (0)
#define PG8_LDA(dst, b, h) do { _Pragma("unroll") for (int m = 0; m < 4; ++m) _Pragma("unroll") for (int k = 0; k < 2; ++k) dst[m][k] = *(const LAS bf16x8*)(lds + PG8_SA(b, h) + aoff + m * 2048 + k * 1024); } while (0)
#define PG8_LDB(dst, b, h) do { _Pragma("unroll") for (int n = 0; n < 2; ++n) _Pragma("unroll") for (int k = 0; k < 2; ++k) dst[n][k] = *(const LAS bf16x8*)(lds + PG8_SB(b, h) + boff + n * 2048 + k * 1024); } while (0)
#define PG8_MMA(ai, bj, At, Bt) do { __builtin_amdgcn_s_setprio(1); _Pragma("unroll") for (int m = 0; m < 4; ++m) _Pragma("unroll") for (int n = 0; n < 2; ++n) _Pragma("unroll") for (int k = 0; k < 2; ++k) \
        acc[ai][bj][m][n] = __builtin_amdgcn_mfma_f32_16x16x32_bf16(Bt[n][k], At[m][k], acc[ai][bj][m][n], 0, 0, 0); __builtin_amdgcn_s_setprio(0); } while (0)
#define PG8_WAIT_V(n) asm volatile("s_waitcnt vmcnt(" #n ")" ::: "memory")
#define PG8_WAIT_L(n) asm volatile("s_waitcnt lgkmcnt(" #n ")" ::: "memory")
#define PG8_BAR __builtin_amdgcn_s_barrier()
#define PG8_SCHED __builtin_amdgcn_sched_barrier(0)
    Unit cur, nxt; int ui = 0;
    if (!S.next(0, cur)) return;
    f32x4 acc[2][2][4][2];
#pragma unroll
    for (int a = 0; a < 2; ++a)
#pragma unroll
        for (int b = 0; b < 2; ++b)
#pragma unroll
            for (int m = 0; m < 4; ++m)
#pragma unroll
                for (int n = 0; n < 2; ++n) acc[a][b][m][n] = (f32x4){0.f, 0.f, 0.f, 0.f};
    bf16x8 At[4][2], B0[2][2], B1[2][2];
    const char* cA = S.a_base(cur); const char* cB = S.b_base(cur);
    unsigned ca0[2] = {0u, 0u}, ca1[2] = {0u, 0u}, na0[2] = {0u, 0u}, na1[2] = {0u, 0u};
    if constexpr (GATHER) {
#pragma unroll
        for (int i = 0; i < 2; ++i) { ca0[i] = S.row_off(cur, sR[i]) + (unsigned)sC2[i]; ca1[i] = S.row_off(cur, HALF + sR[i]) + (unsigned)sC2[i]; }
    }
    PG8_STAGE(PG8_SB(0, 0), cB, voffB); PG8_STAGE(PG8_SB(0, 1), cB + hstep, voffB); PG8_STAGE_A(PG8_SA(0, 0), cA, 0, ca0, ca1); PG8_STAGE_A(PG8_SA(0, 1), cA, 1, ca0, ca1);
    if (wr == 1) PG8_BAR;
    PG8_WAIT_V(2); PG8_BAR;
    PG8_STAGE(PG8_SB(1, 0), cB + kstep, voffB); PG8_STAGE_A(PG8_SA(1, 0), cA + kstep, 0, ca0, ca1); PG8_STAGE(PG8_SB(1, 1), cB + hstep + kstep, voffB);
    PG8_WAIT_V(6); PG8_BAR;
    for (;;) {
        const bool has_next = S.next(ui + 1, nxt);
        const char* nA = has_next ? S.a_base(nxt) : cA; const char* nB = has_next ? S.b_base(nxt) : cB;
        if constexpr (GATHER) {
            if (has_next) {
#pragma unroll
                for (int i = 0; i < 2; ++i) { na0[i] = S.row_off(nxt, sR[i]) + (unsigned)sC2[i]; na1[i] = S.row_off(nxt, HALF + sR[i]) + (unsigned)sC2[i]; }
            } else { na0[0] = ca0[0]; na0[1] = ca0[1]; na1[0] = ca1[0]; na1[1] = ca1[1]; }
        }
        for (int t = 0; t < nt; t += 2) {
            const bool last = (t == nt - 2);
            const char* a1 = cA + (size_t)(t + 1) * kstep;
            const char* a2 = last ? nA : cA + (size_t)(t + 2) * kstep; const char* b2 = last ? nB : cB + (size_t)(t + 2) * kstep;
            const char* a3 = a2 + kstep; const char* b3 = b2 + kstep;
            unsigned x0[2], x1[2];
            x0[0] = last ? na0[0] : ca0[0]; x0[1] = last ? na0[1] : ca0[1]; x1[0] = last ? na1[0] : ca1[0]; x1[1] = last ? na1[1] : ca1[1];
            PG8_LDB(B0, 0, 0); PG8_LDB(B1, 0, 1); PG8_SCHED; PG8_LDA(At, 0, 0); PG8_STAGE_A(PG8_SA(1, 1), a1, 1, ca0, ca1);
            PG8_WAIT_V(8); PG8_WAIT_L(0); PG8_BAR; PG8_MMA(0, 0, At, B0); PG8_MMA(0, 1, At, B1); PG8_BAR; PG8_SCHED;
            PG8_LDA(At, 0, 1); PG8_STAGE(PG8_SB(0, 0), b2, voffB); PG8_STAGE(PG8_SB(0, 1), b2 + hstep, voffB); PG8_STAGE_A(PG8_SA(0, 0), a2, 0, x0, x1);
            PG8_WAIT_V(8); PG8_WAIT_L(0); PG8_BAR; PG8_MMA(1, 0, At, B0); PG8_MMA(1, 1, At, B1); PG8_BAR; PG8_SCHED;
            PG8_LDB(B0, 1, 0); PG8_LDB(B1, 1, 1); PG8_SCHED; PG8_LDA(At, 1, 0); PG8_STAGE_A(PG8_SA(0, 1), a2, 1, x0, x1);
            PG8_WAIT_V(8); PG8_WAIT_L(0); PG8_BAR; PG8_MMA(0, 0, At, B0); PG8_MMA(0, 1, At, B1); PG8_BAR; PG8_SCHED;
            PG8_LDA(At, 1, 1); PG8_STAGE(PG8_SB(1, 0), b3, voffB); PG8_STAGE(PG8_SB(1, 1), b3 + hstep, voffB); PG8_STAGE_A(PG8_SA(1, 0), a3, 0, x0, x1);
            PG8_WAIT_V(8); PG8_WAIT_L(0); PG8_BAR; PG8_MMA(1, 0, At, B0); PG8_MMA(1, 1, At, B1); PG8_BAR; PG8_SCHED;
        }
        if constexpr (ALIGN_EPI) { if (wr == 0) PG8_BAR; }
        E(acc, cur, wr, wc, fr, fq);
        if (!has_next) break;
#pragma unroll
        for (int a = 0; a < 2; ++a)
#pragma unroll
            for (int b = 0; b < 2; ++b)
#pragma unroll
                for (int m = 0; m < 4; ++m)
#pragma unroll
                    for (int n = 0; n < 2; ++n) acc[a][b][m][n] = (f32x4){0.f, 0.f, 0.f, 0.f};
        cur = nxt; cA = nA; cB = nB; ++ui;
        if constexpr (GATHER) { ca0[0] = na0[0]; ca0[1] = na0[1]; ca1[0] = na1[0]; ca1[1] = na1[1]; }
        if constexpr (ALIGN_EPI) { if (wr == 1) PG8_BAR; }
    }
    PG8_WAIT_V(0);
    if constexpr (!ALIGN_EPI) { if (wr == 0) PG8_BAR; }
    PG8_BAR;
#undef PG8_SA
#undef PG8_SB
#undef PG8_STAGE
#undef PG8_STAGE_A
#undef PG8_LDA
#undef PG8_LDB
#undef PG8_MMA
#undef PG8_WAIT_V
#undef PG8_WAIT_L
#undef PG8_BAR
#undef PG8_SCHED
}
}

#define XB_TMO      128
#define XB_XCNT(j)  (256  + 64 * (j))
#define XB_XSUB(j)  (1280 + 64 * (j))
#define XB_XGEN(j)  (2304 + 64 * (j))
#define XB_TOP      3328
#define XB_TOPGEN   3392
#define XCD_BAR_WORDS 3456
#define XB_SPIN_CAP (1u << 22)
__device__ __forceinline__ unsigned xb_ld(unsigned* p)              { return __hip_atomic_load(p, __ATOMIC_RELAXED, __HIP_MEMORY_SCOPE_AGENT); }
__device__ __forceinline__ unsigned xb_add(unsigned* p, unsigned v) { return __hip_atomic_fetch_add(p, v, __ATOMIC_RELAXED, __HIP_MEMORY_SCOPE_AGENT); }
__device__ __forceinline__ unsigned xb_xcc_id() { return (unsigned)__builtin_amdgcn_s_getreg((3 << 11) | 20) & 0xFu; }
#define XB_SPIN(cond, bar) do { unsigned _sp = 0; while (cond) { __builtin_amdgcn_s_sleep(1); \
    if ((++_sp & 255u) == 0u) { if (xb_ld(&(bar)[XB_TMO])) break; if (_sp > XB_SPIN_CAP) { atomicAdd(&(bar)[XB_TMO], 1u); break; } } } } while (0)
struct XcdBarrier { unsigned* bar; unsigned x; volatile LAS unsigned* st; };
__device__ __forceinline__ XcdBarrier xcd_barrier_post(unsigned* bar, volatile LAS unsigned* st) {
    XcdBarrier b; b.bar = bar; b.x = xb_xcc_id(); b.st = st;
    if (threadIdx.x == 0) (void)xb_add(&bar[XB_XCNT(b.x)], 1u);
    return b;
}
__device__ __forceinline__ void xcd_barrier_complete(unsigned* bar, unsigned x, unsigned& nloc, unsigned& nx) {
    const unsigned G = gridDim.x * gridDim.y * gridDim.z;
    unsigned sum, cnt, mine, sp = 0u;
    for (;;) {
        sum = 0u; cnt = 0u; mine = 0u;
#pragma unroll
        for (unsigned j = 0; j < 16; ++j) { const unsigned c = xb_ld(&bar[XB_XCNT(j)]); sum += c; cnt += (c > 0u) ? 1u : 0u; mine = (j == x) ? c : mine; }
        if (sum == G) break;
        __builtin_amdgcn_s_sleep(1);
        if ((++sp & 255u) == 0u) { if (xb_ld(&bar[XB_TMO])) break; if (sp > XB_SPIN_CAP) { atomicAdd(&bar[XB_TMO], 1u); break; } }
    }
    nloc = mine > 0u ? mine : 1u; nx = cnt > 0u ? cnt : 1u;
}
__device__ __forceinline__ void xcd_barrier(const XcdBarrier& b) {
    asm volatile("s_waitcnt vmcnt(0)" ::: "memory");
    __syncthreads();
    if (threadIdx.x == 0) {
        unsigned* bar = b.bar;
        __builtin_amdgcn_s_waitcnt(0);
        unsigned nloc = b.st[0], nx = b.st[1];
        if (nloc == 0u) { xcd_barrier_complete(bar, b.x, nloc, nx); b.st[0] = nloc; b.st[1] = nx; }
        const unsigned old = xb_add(&bar[XB_XSUB(b.x)], 1u);
        const unsigned gen = old / nloc;
        if (old + 1u == (gen + 1u) * nloc) {
            __builtin_amdgcn_fence(__ATOMIC_RELEASE, "agent");
            asm volatile("s_waitcnt vmcnt(0)" ::: "memory");
            const unsigned og = xb_add(&bar[XB_TOP], 1u);
            const unsigned tg = og / nx;
            if (og + 1u == (tg + 1u) * nx) xb_add(&bar[XB_TOPGEN], 1u);
            else XB_SPIN(xb_ld(&bar[XB_TOPGEN]) == tg, bar);
            __builtin_amdgcn_fence(__ATOMIC_ACQUIRE, "agent");
            xb_add(&bar[XB_XGEN(b.x)], 1u);
            asm volatile("s_waitcnt vmcnt(0)" ::: "memory");
        } else {
            XB_SPIN(xb_ld(&bar[XB_XGEN(b.x)]) == gen, bar);
            __builtin_amdgcn_fence(__ATOMIC_ACQUIRE, "agent");
            asm volatile("s_waitcnt vmcnt(0)" ::: "memory");
        }
    }
    __syncthreads();
}

enum { I_X = 0, I_C, I_CTX, I_CCTX, I_N1G, I_N2G, I_WMOD, I_BMOD, I_WIN, I_QG, I_KG, I_CONVW, I_CONVB, I_LNG, I_LNB, I_SINK, I_WOUT, I_WGRP, I_BGRP, I_WEXP, I_BEXP, I_WGATE, I_WUP, I_WDOWN, I_FING, N_IN };
struct Args { const float* in[N_IN]; float* out; unsigned char* ws; int ph_lo, ph_hi; };
struct Frame {
    LAS unsigned char* lds;
    int tid, lane, wave, G, vcu;
    const float* const* in; float* out; unsigned char* ws;
};
__device__ __forceinline__ void frame_ids(Frame& F) { int t = threadIdx.x; asm volatile("" : "+v"(t)); F.tid = t; F.lane = t & 63; F.wave = __builtin_amdgcn_readfirstlane(t >> 6); }
constexpr int NPH_LAYER = 7, PH_FINAL = 1 + NPH_LAYER * DEPTH, NPHASES = PH_FINAL + 1;

__device__ __forceinline__ int win_dest_row(int o) {
    int tile, c;
    auto cpos = [](int d, int wc) { const int a = d >> 5, t = (d >> 4) & 1, f = d & 15; return 128 * a + 32 * wc + 8 * (f >> 2) + 4 * t + (f & 3); };
    if (o < 384) { const int h = o >> 6; tile = h >> 2; c = cpos(o & 63, h & 3); }
    else if (o < 512) { const int kh = (o - 384) >> 6; tile = 1; c = cpos(o & 63, 2 + kh); }
    else if (o < 640) { tile = 4; c = o - 512; }
    else if (o < 896) { const int j = o - 640; tile = 5 + (j >> 7); c = j & 127; }
    else if (o < 1152) { const int j = o - 896; tile = 5 + (j >> 7); c = 128 + (j & 127); }
    else if (o < 1536) { const int h = (o - 1152) >> 6; tile = 2 + (h >> 2); c = cpos(o & 63, h & 3); }
    else if (o < 1664) { const int kh = (o - 1536) >> 6; tile = 3; c = cpos(o & 63, 2 + kh); }
    else { tile = 4; c = 128 + (o - 1664); }
    return tile * 256 + c;
}
template <bool PERMW = false>
__device__ __forceinline__ void transpose_item(const float* W, int K, int N, int k0, int n0, bf16_t* dst_rows, LAS float* scr, int lane) {
#pragma unroll 8
    for (int i = 0; i < 32; ++i) { const int kk = 2 * i + (lane >> 5); scr[kk * 33 + (lane & 31)] = W[(size_t)(k0 + kk) * N + n0 + (lane & 31)]; }
    LDS_WAIT();
    const int c = lane & 7;
#pragma unroll
    for (int j = 0; j < 4; ++j) { const int n = (lane >> 3) + 8 * j; const LAS float* s = scr + (8 * c) * 33 + n;
        u32x4 o; o.x = pk2(s[0 * 33], s[1 * 33]); o.y = pk2(s[2 * 33], s[3 * 33]); o.z = pk2(s[4 * 33], s[5 * 33]); o.w = pk2(s[6 * 33], s[7 * 33]);
        const int drow = PERMW ? win_dest_row(n0 + n) : n;
        *(u32x4*)(dst_rows + (size_t)drow * K + k0 + 8 * c) = o; }
    LDS_WAIT();
}
__device__ __forceinline__ void p0_prologue(Frame& F) {
    frame_ids(F);
    LAS float* scr = (LAS float*)(F.lds + F.wave * 16384);
    const int gw = F.vcu * 8 + F.wave, NGW = F.G * 8;
    bf16_t* Win_t = (bf16_t*)(F.ws + WS_WIN); bf16_t* Wout_t = (bf16_t*)(F.ws + WS_WOUT); bf16_t* Wgu_t = (bf16_t*)(F.ws + WS_WGU); bf16_t* Wd_t = (bf16_t*)(F.ws + WS_WD);
    constexpr int T_IN = DEPTH * 16 * 56, T_OUT = DEPTH * 16 * 32, T_G = DEPTH * NE * 16 * 16, T_D = DEPTH * NE * 8 * 32;
    constexpr int NITEMS = T_IN + T_OUT + 2 * T_G + T_D;
    for (int it = gw; it < NITEMS; it += NGW) {
        int r = it;
        if (r < T_IN) { const int l = r / 896, q = r % 896, kb = q / 56, nb = q % 56;
            transpose_item<true>(F.in[I_WIN] + (size_t)l * D * DIN, D, DIN, 64 * kb, 32 * nb, Win_t + (size_t)l * DIN * D, scr, F.lane); continue; }
        r -= T_IN;
        if (r < T_OUT) { const int l = r / 512, q = r % 512, kb = q / 32, nb = q % 32;
            transpose_item(F.in[I_WOUT] + (size_t)l * DMIX * D, DMIX, D, 64 * kb, 32 * nb, Wout_t + ((size_t)l * D + 32 * nb) * DMIX, scr, F.lane); continue; }
        r -= T_OUT;
        if (r < 2 * T_G) { const int up = r >= T_G; if (up) r -= T_G; const int mat = r / 256, q = r % 256, kb = q / 16, nb = q % 16, n0 = 32 * nb;
            const int drow = 256 * (n0 / 128) + (n0 % 128) + (up ? 128 : 0);
            transpose_item(F.in[up ? I_WUP : I_WGATE] + (size_t)mat * D * DE, D, DE, 64 * kb, n0, Wgu_t + ((size_t)mat * 1024 + drow) * D, scr, F.lane); continue; }
        r -= 2 * T_G;
        { const int mat = r / 256, q = r % 256, kb = q / 32, nb = q % 32;
            transpose_item(F.in[I_WDOWN] + (size_t)mat * DE * D, DE, D, 64 * kb, 32 * nb, Wd_t + ((size_t)mat * D + 32 * nb) * DE, scr, F.lane); }
    }
    { float* rope = (float*)(F.ws + WS_ROPE); const int gt = F.vcu * 512 + F.tid;
      if (gt < 1024) { const int pos = gt >> 4, f = gt & 15; const float inv = powf(10000.0f, -(float)f / 16.0f); const float ang = (float)pos * inv; rope[gt] = cosf(ang); rope[1024 + gt] = sinf(ang); } }
    __syncthreads();
    { LAS float* sc = (LAS float*)F.lds;
      float* mod = (float*)(F.ws + WS_MOD);
      for (int un = F.vcu; un < DEPTH * 192; un += F.G) {
          const int l = un / 192, n0 = (un % 192) * 32;
          for (int idx = F.tid; idx < 33 * 1024; idx += 512) { const int r = idx >> 10, k = idx & 1023; const float v = r < 32 ? F.in[I_C][r * 1024 + k] : F.in[I_CCTX][k]; sc[idx] = v / (1.0f + __expf(-v)); }
          __syncthreads();
          const int col = F.tid & 31, kg = F.tid >> 5;
          float acc[33];
#pragma unroll
          for (int r = 0; r < 33; ++r) acc[r] = 0.f;
          const float* wp = F.in[I_WMOD] + ((size_t)l * D + kg * 64) * (NMOD * D) + n0 + col;
          for (int k = 0; k < 64; ++k) { const float w = wp[(size_t)k * (NMOD * D)];
#pragma unroll
              for (int r = 0; r < 33; ++r) acc[r] += sc[r * 1024 + kg * 64 + k] * w; }
#pragma unroll
          for (int r = 0; r < 33; ++r) acc[r] += __shfl_xor(acc[r], 32);
          __syncthreads();
          LAS float* red = (LAS float*)F.lds;
          if (F.lane < 32) {
#pragma unroll
              for (int r = 0; r < 33; ++r) red[(F.wave * 33 + r) * 32 + col] = acc[r]; }
          __syncthreads();
          for (int idx = F.tid; idx < 33 * 32; idx += 512) { const int r = idx >> 5, cc = idx & 31; float s = 0.f;
#pragma unroll
              for (int w = 0; w < 8; ++w) s += red[(w * 33 + r) * 32 + cc];
              mod[((size_t)l * 33 + r) * (NMOD * D) + n0 + cc] = s + F.in[I_BMOD][l * (NMOD * D) + n0 + cc]; }
          __syncthreads();
      }
    }
}

__device__ __forceinline__ void build_tstart(Frame& F, int layer) {
    frame_ids(F);
    LAS int* ts = (LAS int*)(F.lds + LDS_MISC) + 16;
    if (F.tid == 0) { const unsigned* cnt = (const unsigned*)(F.ws + WS_CTL) + CW_CNT + layer * NE; int s = 0;
        for (int e = 0; e < NE; ++e) { ts[e] = s; s += ((int)cnt[e] + 255) >> 8; } ts[NE] = s; }
    __syncthreads();
}
template <int MODE>
__device__ __forceinline__ void p_norm(Frame& F, int layer, int comb_layer, int nrows, bool dry = false) {
    frame_ids(F);
    const int gw = F.vcu * 8 + F.wave, NGW = F.G * 8;
    const float* mod = (const float*)(F.ws + WS_MOD);
    const bf16_t* Y = (const bf16_t*)(F.ws + WS_PROJ);
    const u32x4* slot = (const u32x4*)(F.ws + WS_SLOT);
    bf16_t* H = (bf16_t*)(F.ws + WS_H);
    const LAS int* ts = (const LAS int*)(F.lds + LDS_MISC) + 16;
    if (comb_layer >= 0) build_tstart(F, comb_layer);
    const float* gptr = MODE == 0 ? F.in[I_N1G] + layer * D : F.in[I_FING];
    f32x4 g[4];
#pragma unroll
    for (int j = 0; j < 4; ++j) g[j] = *(const f32x4*)(gptr + 4 * F.lane + 256 * j);
    for (int r = gw; r < nrows; r += NGW) {
        const bool lat = r < NLAT; const int mrow = lat ? r / SEQ : BATCH;
        const float* xin; float* xout;
        if (lat) { xout = F.out + (size_t)r * D; xin = (layer == 0 && MODE == 0) ? F.in[I_X] + (size_t)r * D : xout; }
        else { xout = (float*)(F.ws + WS_XC) + (size_t)(r - NLAT) * D; xin = (layer == 0 && MODE == 0) ? F.in[I_CTX] + (size_t)(r - NLAT) * D : xout; }
        f32x4 v[4];
#pragma unroll
        for (int j = 0; j < 4; ++j) v[j] = *(const f32x4*)(xin + 4 * F.lane + 256 * j);
        if (comb_layer >= 0) {
            const u32x4 si = slot[r];
            const int e0 = si.x >> 20, e1 = si.y >> 20;
            const size_t p0 = (size_t)ts[e0] * 256 + (si.x & 0xfffffu), p1 = (size_t)ts[e1] * 256 + (si.y & 0xfffffu);
            const float w0 = __uint_as_float(si.z), w1 = __uint_as_float(si.w);
            const float* g2 = mod + ((size_t)comb_layer * 33 + mrow) * (NMOD * D) + 5 * D;
#pragma unroll
            for (int j = 0; j < 4; ++j) {
                const u32x2 a = *(const u32x2*)(Y + p0 * D + 4 * F.lane + 256 * j), b = *(const u32x2*)(Y + p1 * D + 4 * F.lane + 256 * j);
                const f32x4 gg = *(const f32x4*)(g2 + 4 * F.lane + 256 * j);
                f32x4 ya = {bf2f(a.x & 0xffffu), bf2f(a.x >> 16), bf2f(a.y & 0xffffu), bf2f(a.y >> 16)};
                f32x4 yb = {bf2f(b.x & 0xffffu), bf2f(b.x >> 16), bf2f(b.y & 0xffffu), bf2f(b.y >> 16)};
                v[j] = v[j] + gg * (ya * w0 + yb * w1);
                if (MODE == 0 && !dry) *(f32x4*)(xout + 4 * F.lane + 256 * j) = v[j];
            }
        }
        float ss = 0.f;
#pragma unroll
        for (int j = 0; j < 4; ++j) ss += (v[j].x * v[j].x + v[j].y * v[j].y) + (v[j].z * v[j].z + v[j].w * v[j].w);
        const float rstd = 1.0f / sqrtf(wave_sum(ss) * (1.0f / D) + EPS);
        if (MODE == 0) {
            const float* mp = mod + ((size_t)layer * 33 + mrow) * (NMOD * D);
#pragma unroll
            for (int j = 0; j < 4; ++j) { const f32x4 sh = *(const f32x4*)(mp + 4 * F.lane + 256 * j), sc = *(const f32x4*)(mp + D + 4 * F.lane + 256 * j);
                const f32x4 h = (v[j] * rstd * g[j]) * (sc + 1.0f) + sh;
                u32x2 o; o.x = pk2(h.x, h.y); o.y = pk2(h.z, h.w);
                *(u32x2*)(H + (size_t)r * D + 4 * F.lane + 256 * j) = o; }
        } else {
#pragma unroll
            for (int j = 0; j < 4; ++j) *(f32x4*)(xout + 4 * F.lane + 256 * j) = v[j] * rstd * g[j];
        }
    }
}

struct AttnUnit { int qrow0, qpos0, qcol, kcol, vcol, ocol, krow_ctx, krow_band, nband, kpos0, masked, has_sink; float sink2; };
__device__ __forceinline__ int crow(int r, int hi) { return (r & 3) + 8 * (r >> 2) + 4 * hi; }
__device__ __forceinline__ s16x4 vtr(const LAS unsigned char* p) { typedef short v4i16_t __attribute__((ext_vector_type(4))); return __builtin_bit_cast(s16x4, __builtin_amdgcn_ds_read_tr16_b64_v4i16((LAS v4i16_t*)p)); }
constexpr int AT_PITCH = 144, AT_K = 0, AT_V = 64 * AT_PITCH, AT_WS = 2 * 64 * AT_PITCH;
__device__ __forceinline__ void attn_unit_v1(const AttnUnit& u, const bf16_t* proj, bf16_t* mix, LAS unsigned char* lds) {
    int tid = threadIdx.x; asm volatile("" : "+v"(tid));
    const int lane = tid & 63, r32 = lane & 31, hi = lane >> 5; const int wid = __builtin_amdgcn_readfirstlane(tid >> 6);
    LAS unsigned char* Ks = lds + AT_K; LAS unsigned char* Vs = lds + AT_V; LAS float* wsf = (LAS float*)(lds + AT_WS) + wid * 64;
    const bf16_t* qp = proj + (size_t)(u.qrow0 + wid * 32 + r32) * PP + u.qcol + 8 * hi;
    bf16x8 qf[4];
#pragma unroll
    for (int d0 = 0; d0 < 4; ++d0) qf[d0] = *(const bf16x8*)(qp + 16 * d0);
    float m = -INFINITY, l = 0.f; f32x16 o0 = {}, o1 = {};
    const int srow = tid >> 3, sch = tid & 7;
    const int ntile = 4 + u.nband;
    const int vq = (lane & 15) >> 2, vp = lane & 3, vg = (lane >> 4) & 1;
    const LAS unsigned char* vbase = Vs + (4 * hi + vq) * AT_PITCH + (16 * vg + 4 * vp) * 2;
    for (int t = 0; t < ntile; ++t) {
        const int krow = (t < 4) ? u.krow_ctx + 64 * t : u.krow_band + 64 * (t - 4);
        const bf16_t* src = proj + (size_t)(krow + srow) * PP + sch * 8;
        const u32x4 kv = *(const u32x4*)(src + u.kcol); const u32x4 vv = *(const u32x4*)(src + u.vcol);
        __syncthreads();
        *(LAS u32x4*)(Ks + srow * AT_PITCH + sch * 16) = kv; *(LAS u32x4*)(Vs + srow * AT_PITCH + sch * 16) = vv;
        __syncthreads();
        f32x16 p0 = {}, p1 = {};
#pragma unroll
        for (int d0 = 0; d0 < 4; ++d0) {
            const bf16x8 a0 = *(const LAS bf16x8*)(Ks + r32 * AT_PITCH + (16 * d0 + 8 * hi) * 2);
            const bf16x8 a1 = *(const LAS bf16x8*)(Ks + (32 + r32) * AT_PITCH + (16 * d0 + 8 * hi) * 2);
            p0 = __builtin_amdgcn_mfma_f32_32x32x16_bf16(a0, qf[d0], p0, 0, 0, 0);
            p1 = __builtin_amdgcn_mfma_f32_32x32x16_bf16(a1, qf[d0], p1, 0, 0, 0);
        }
        if (u.masked && t >= 4) {
            const int qpos = u.qpos0 + wid * 32 + r32, kb = u.kpos0 + 64 * (t - 4) + 4 * hi;
#pragma unroll
            for (int r = 0; r < 16; ++r) { const int dd = kb + (r & 3) + 8 * (r >> 2) - qpos;
                if (dd > 128 || dd < -128) p0[r] = -INFINITY;
                if (dd + 32 > 128 || dd + 32 < -128) p1[r] = -INFINITY; }
        }
        float mx = fmaxf(p0[0], p1[0]);
#pragma unroll
        for (int r = 1; r < 16; ++r) mx = fmaxf(mx, fmaxf(p0[r], p1[r]));
        mx = fmaxf(mx, __shfl_xor(mx, 32));
        const float mn = fmaxf(m, mx);
        const float alpha = __builtin_amdgcn_exp2f(m - mn);
        float ls = 0.f;
#pragma unroll
        for (int r = 0; r < 16; ++r) { p0[r] = __builtin_amdgcn_exp2f(p0[r] - mn); p1[r] = __builtin_amdgcn_exp2f(p1[r] - mn); ls += p0[r] + p1[r]; }
        l = l * alpha + ls; m = mn;
        if (hi == 0) wsf[r32] = alpha;
        LDS_WAIT();
#pragma unroll
        for (int r = 0; r < 16; ++r) { const float a = wsf[crow(r, hi)]; o0[r] *= a; o1[r] *= a; }
        bf16x8 pa[4];
#pragma unroll
        for (int ks = 0; ks < 4; ++ks) {
            u32x4 w;
            if (ks < 2) { const int b = 8 * ks; w.x = pk2(p0[b], p0[b + 1]); w.y = pk2(p0[b + 2], p0[b + 3]); w.z = pk2(p0[b + 4], p0[b + 5]); w.w = pk2(p0[b + 6], p0[b + 7]); }
            else { const int b = 8 * (ks - 2); w.x = pk2(p1[b], p1[b + 1]); w.y = pk2(p1[b + 2], p1[b + 3]); w.z = pk2(p1[b + 4], p1[b + 5]); w.w = pk2(p1[b + 6], p1[b + 7]); }
            pa[ks] = __builtin_bit_cast(bf16x8, w);
        }
#pragma unroll
        for (int ks = 0; ks < 4; ++ks) {
            const int kb = 32 * (ks >> 1) + 16 * (ks & 1);
#pragma unroll
            for (int d0 = 0; d0 < 2; ++d0) {
                const s16x4 lo = vtr(vbase + kb * AT_PITCH + d0 * 64), hh = vtr(vbase + (kb + 8) * AT_PITCH + d0 * 64);
                const bf16x8 vf = {lo[0], lo[1], lo[2], lo[3], hh[0], hh[1], hh[2], hh[3]};
                if (d0 == 0) o0 = __builtin_amdgcn_mfma_f32_32x32x16_bf16(pa[ks], vf, o0, 0, 0, 0);
                else o1 = __builtin_amdgcn_mfma_f32_32x32x16_bf16(pa[ks], vf, o1, 0, 0, 0);
            }
        }
    }
    l += __shfl_xor(l, 32);
    if (u.has_sink) l += __builtin_amdgcn_exp2f(u.sink2 - m);
    LDS_WAIT();
    if (hi == 0) wsf[32 + r32] = l;
    LDS_WAIT();
#pragma unroll
    for (int r = 0; r < 16; ++r) { const int q = crow(r, hi); const float rl = 1.0f / wsf[32 + q];
        bf16_t* op = mix + (size_t)(u.qrow0 + wid * 32 + q) * DMIX + u.ocol + r32;
        op[0] = (bf16_t)f2bf(o0[r] * rl); op[32] = (bf16_t)f2bf(o1[r] * rl); }
    LDS_WAIT();
}
constexpr int CV_H = 0, CV_W = 49152;
__device__ __forceinline__ void conv_unit(Frame& F, int layer, int R0, int L, int t0, const bf16_t* proj, bf16_t* mix) {
    LAS unsigned char* hs = F.lds + CV_H; const LAS float* cw = (const LAS float*)(F.lds + CV_W);
    __syncthreads();
    for (int idx = F.tid; idx < 94 * 32; idx += 512) { const int row = idx >> 5, ch = idx & 31, tp = t0 - 15 + row;
        u32x4 v = {0u, 0u, 0u, 0u};
        if (tp >= 0 && tp < L) v = *(const u32x4*)(proj + (size_t)(R0 + tp) * PP + C_BU + ch * 8);
        *(LAS u32x4*)(hs + row * 512 + ch * 16) = v; }
    __syncthreads();
    const int c4 = F.lane * 4;
    const f32x4 bias = *(const f32x4*)(F.in[I_CONVB] + layer * BCH + c4), lg = *(const f32x4*)(F.in[I_LNG] + layer * BCH + c4), lb = *(const f32x4*)(F.in[I_LNB] + layer * BCH + c4);
    for (int i = 0; i < 8; ++i) {
        const int tt = F.wave * 8 + i;
        f32x4 acc = bias;
#pragma unroll
        for (int k = 0; k < CONVW; ++k) { const u32x2 xr = *(const LAS u32x2*)(hs + (tt + k) * 512 + F.lane * 8); const f32x4 wv = *(const LAS f32x4*)(cw + k * 256 + c4);
            acc.x += bf2f(xr.x & 0xffffu) * wv.x; acc.y += bf2f(xr.x >> 16) * wv.y; acc.z += bf2f(xr.y & 0xffffu) * wv.z; acc.w += bf2f(xr.y >> 16) * wv.w; }
        const float mean = wave_sum((acc.x + acc.y) + (acc.z + acc.w)) * (1.0f / BCH);
        const f32x4 d = acc - mean;
        const float var = wave_sum((d.x * d.x + d.y * d.y) + (d.z * d.z + d.w * d.w)) * (1.0f / BCH);
        const f32x4 y = d * (1.0f / sqrtf(var + EPS)) * lg + lb;
        f32x4 s; s.x = y.x / (1.0f + __expf(-y.x)); s.y = y.y / (1.0f + __expf(-y.y)); s.z = y.z / (1.0f + __expf(-y.z)); s.w = y.w / (1.0f + __expf(-y.w));
        u32x2 o; o.x = pk2(s.x, s.y); o.y = pk2(s.z, s.w);
        *(u32x2*)(mix + (size_t)(R0 + t0 + tt) * DMIX + O_B + c4) = o;
    }
}
__device__ __forceinline__ void p4_mixers(Frame& F, int layer) {
    frame_ids(F);
    const bf16_t* proj = (const bf16_t*)(F.ws + WS_PROJ); bf16_t* mix = (bf16_t*)(F.ws + WS_H);
    const bool with_ctx = layer < DEPTH - 1;
    const int n_att = 3072 + (with_ctx ? 384 : 0);
    for (int un = F.vcu; un < n_att; un += F.G) {
        AttnUnit u; int kind, idx;
        if (un < 1536) { kind = 0; idx = un; } else if (un < 3072) { kind = 1; idx = un - 1536; } else if (un < 3264) { kind = 2; idx = un - 3072; } else { kind = 3; idx = un - 3264; }
        const bool isC = kind & 1, isctx = kind >= 2;
        int b, h, qb;
        if (!isctx) { qb = idx & 7; h = (idx >> 3) % 6; b = idx / 48; } else { qb = 0; h = idx % 6; b = idx / 6; }
        const int kvh = h / 3;
        u.qcol = (isC ? C_CQ : C_AQ) + h * 64; u.kcol = (isC ? C_CK : C_AK) + kvh * 64; u.vcol = (isC ? C_CV : C_AV) + kvh * 64; u.ocol = (isC ? O_C : O_A) + h * 64;
        u.krow_ctx = NLAT + b * CTXL;
        u.has_sink = isC; u.sink2 = isC ? F.in[I_SINK][layer * 6 + h] * LOG2E : 0.f;
        if (isctx) { u.qrow0 = NLAT + b * CTXL; u.qpos0 = 0; u.nband = 0; u.krow_band = 0; u.kpos0 = 0; u.masked = 0; }
        else {
            u.qrow0 = b * SEQ + qb * 256; u.qpos0 = qb * 256;
            if (isC) { const int ks = qb * 256 - 128 < 0 ? 0 : qb * 256 - 128, ke = qb * 256 + 384 > SEQ ? SEQ : qb * 256 + 384;
                u.kpos0 = ks; u.nband = (ke - ks) >> 6; u.krow_band = b * SEQ + ks; u.masked = 1; }
            else { u.kpos0 = 0; u.nband = SEQ / 64; u.krow_band = b * SEQ; u.masked = 0; }
        }
        attn_unit_v1(u, proj, mix, F.lds);
        if ((REP_MASK & 4) && !isC) attn_unit_v1(u, proj, mix, F.lds);
        if ((REP_MASK & 8) && isC) attn_unit_v1(u, proj, mix, F.lds);
    }
    __syncthreads();
    { LAS float* cw = (LAS float*)(F.lds + CV_W);
      for (int idx = F.tid; idx < CONVW * BCH; idx += 512) cw[idx] = F.in[I_CONVW][layer * CONVW * BCH + idx]; }
    const int n_conv = 1024 + (with_ctx ? 128 : 0);
    for (int un = F.vcu; un < n_conv; un += F.G) {
        if (un < 1024) conv_unit(F, layer, (un >> 5) * SEQ, SEQ, (un & 31) * 64, proj, mix);
        else conv_unit(F, layer, NLAT + ((un - 1024) >> 2) * CTXL, CTXL, ((un - 1024) & 3) * 64, proj, mix);
        if (REP_MASK & 16) { if (un < 1024) conv_unit(F, layer, (un >> 5) * SEQ, SEQ, (un & 31) * 64, proj, mix);
            else conv_unit(F, layer, NLAT + ((un - 1024) >> 2) * CTXL, CTXL, ((un - 1024) & 3) * 64, proj, mix); }
    }
    __syncthreads();
}

constexpr int RT_PITCH = 2064;
constexpr int RT_AH = 0, RT_AL = 16 * RT_PITCH, RT_RED = 2 * 16 * RT_PITCH, RT_FIN = RT_RED + 8 * 16 * 48 * 4;
__device__ __forceinline__ void p6_router(Frame& F, int layer, int nrows, bool commit = true) {
    frame_ids(F);
    LAS unsigned char* AH = F.lds + RT_AH; LAS unsigned char* AL = F.lds + RT_AL;
    LAS float* RED = (LAS float*)(F.lds + RT_RED); LAS float* FIN = (LAS float*)(F.lds + RT_FIN);
    LAS unsigned* rec = (LAS unsigned*)(F.lds + LDS_REC);
    LAS unsigned* hist = (LAS unsigned*)(F.lds + LDS_MISC) + 64; LAS unsigned* base = (LAS unsigned*)(F.lds + LDS_MISC) + 96;
    const float* wg = F.in[I_WGRP] + (size_t)layer * D * 4; const float* we = F.in[I_WEXP] + (size_t)layer * D * NE;
    if (F.tid < NE) hist[F.tid] = 0u;
    const int fr = F.lane & 15, kq = F.lane >> 4;
    bf16x8 bh[3][4], bl[3][4];
#pragma unroll
    for (int nt = 0; nt < 3; ++nt)
#pragma unroll
        for (int ks = 0; ks < 4; ++ks) {
            const int col = 16 * nt + fr;
#pragma unroll
            for (int j = 0; j < 8; ++j) { const int k = 128 * F.wave + 32 * ks + 8 * kq + j;
                const float w = col < 4 ? wg[k * 4 + col] : (col < 36 ? we[k * NE + col - 4] : 0.f);
                const unsigned hi = f2bf(w); const unsigned lo = f2bf(w - bf2f(hi));
                bh[nt][ks][j] = (short)hi; bl[nt][ks][j] = (short)lo; }
        }
    const int rpb = (nrows + F.G - 1) / F.G, rbeg = F.vcu * rpb, rend = rbeg + rpb < nrows ? rbeg + rpb : nrows;
    const float* mod = (const float*)(F.ws + WS_MOD); bf16_t* H = (bf16_t*)(F.ws + WS_H);
    f32x4 g[4];
#pragma unroll
    for (int j = 0; j < 4; ++j) g[j] = *(const f32x4*)(F.in[I_N2G] + layer * D + 4 * F.lane + 256 * j);
    const float* bgp = F.in[I_BGRP] + layer * 4; const float* bep = F.in[I_BEXP] + layer * NE;
    __syncthreads();
    for (int gb = rbeg; gb < rend; gb += 16) {
#pragma unroll
        for (int q = 0; q < 2; ++q) {
            const int lr = 2 * F.wave + q; const bool valid = gb + lr < rend; const int r = valid ? gb + lr : rend - 1;
            const bool lat = r < NLAT; const int mrow = lat ? r / SEQ : BATCH;
            const float* xin = lat ? F.out + (size_t)r * D : (const float*)(F.ws + WS_XC) + (size_t)(r - NLAT) * D;
            f32x4 v[4]; float ss = 0.f;
#pragma unroll
            for (int j = 0; j < 4; ++j) { v[j] = *(const f32x4*)(xin + 4 * F.lane + 256 * j); ss += (v[j].x * v[j].x + v[j].y * v[j].y) + (v[j].z * v[j].z + v[j].w * v[j].w); }
            const float rstd = 1.0f / sqrtf(wave_sum(ss) * (1.0f / D) + EPS);
            const float* mp = mod + ((size_t)layer * 33 + mrow) * (NMOD * D) + 3 * D;
#pragma unroll
            for (int j = 0; j < 4; ++j) { const f32x4 sh = *(const f32x4*)(mp + 4 * F.lane + 256 * j), sc = *(const f32x4*)(mp + D + 4 * F.lane + 256 * j);
                const f32x4 h = (v[j] * rstd * g[j]) * (sc + 1.0f) + sh;
                const unsigned h0 = f2bf(h.x), h1 = f2bf(h.y), h2 = f2bf(h.z), h3 = f2bf(h.w);
                u32x2 o; o.x = h0 | (h1 << 16); o.y = h2 | (h3 << 16);
                u32x2 lo; lo.x = pk2(h.x - bf2f(h0), h.y - bf2f(h1)); lo.y = pk2(h.z - bf2f(h2), h.w - bf2f(h3));
                if (valid) *(u32x2*)(H + (size_t)r * D + 4 * F.lane + 256 * j) = o;
                *(LAS u32x2*)(AH + lr * RT_PITCH + (4 * F.lane + 256 * j) * 2) = o;
                *(LAS u32x2*)(AL + lr * RT_PITCH + (4 * F.lane + 256 * j) * 2) = lo; }
        }
        __syncthreads();
        f32x4 acc[3] = {{0.f, 0.f, 0.f, 0.f}, {0.f, 0.f, 0.f, 0.f}, {0.f, 0.f, 0.f, 0.f}};
#pragma unroll
        for (int ks = 0; ks < 4; ++ks) {
            const bf16x8 ah = *(const LAS bf16x8*)(AH + fr * RT_PITCH + (128 * F.wave + 32 * ks + 8 * kq) * 2);
            const bf16x8 al = *(const LAS bf16x8*)(AL + fr * RT_PITCH + (128 * F.wave + 32 * ks + 8 * kq) * 2);
#pragma unroll
            for (int nt = 0; nt < 3; ++nt) {
                acc[nt] = __builtin_amdgcn_mfma_f32_16x16x32_bf16(ah, bh[nt][ks], acc[nt], 0, 0, 0);
                acc[nt] = __builtin_amdgcn_mfma_f32_16x16x32_bf16(ah, bl[nt][ks], acc[nt], 0, 0, 0);
                acc[nt] = __builtin_amdgcn_mfma_f32_16x16x32_bf16(al, bh[nt][ks], acc[nt], 0, 0, 0);
            }
        }
#pragma unroll
        for (int nt = 0; nt < 3; ++nt)
#pragma unroll
            for (int i = 0; i < 4; ++i) RED[(F.wave * 16 + 4 * kq + i) * 48 + 16 * nt + fr] = acc[nt][i];
        __syncthreads();
        { const int row = F.tid >> 5, e = F.tid & 31; float s = 0.f;
#pragma unroll
          for (int w = 0; w < 8; ++w) s += RED[(w * 16 + row) * 48 + 4 + e];
          FIN[row * 36 + 4 + e] = s;
          if (F.tid < 64) { const int r2 = F.tid >> 2, gi = F.tid & 3; float s2 = 0.f;
#pragma unroll
              for (int w = 0; w < 8; ++w) s2 += RED[(w * 16 + r2) * 48 + gi];
              FIN[r2 * 36 + gi] = s2; } }
        __syncthreads();
        if (F.tid < 16 && gb + F.tid < rend && commit) {
            const LAS float* fl = FIN + F.tid * 36;
            float gl[4];
#pragma unroll
            for (int gi = 0; gi < 4; ++gi) gl[gi] = fl[gi] + bgp[gi];
            int gidx = 0; float gmax = gl[0];
#pragma unroll
            for (int gi = 1; gi < 4; ++gi) if (gl[gi] > gmax) { gmax = gl[gi]; gidx = gi; }
            float gsum = 0.f;
#pragma unroll
            for (int gi = 0; gi < 4; ++gi) gsum += __expf(gl[gi] - gmax);
            const float gval = 1.0f / gsum;
            float el[8];
#pragma unroll
            for (int j = 0; j < 8; ++j) el[j] = fl[4 + gidx * 8 + j] + bep[gidx * 8 + j];
            int i0 = 0; float v0 = el[0];
#pragma unroll
            for (int j = 1; j < 8; ++j) if (el[j] > v0) { v0 = el[j]; i0 = j; }
            int i1 = -1; float v1 = -INFINITY;
#pragma unroll
            for (int j = 0; j < 8; ++j) if (j != i0 && el[j] > v1) { v1 = el[j]; i1 = j; }
            const float t = __expf(v1 - v0), w0 = gval / (1.0f + t), w1 = gval * t / (1.0f + t);
            const int e0 = gidx * 8 + i0, e1 = gidx * 8 + i1;
            const unsigned x0 = atomicAdd((unsigned*)&hist[e0], 1u), x1 = atomicAdd((unsigned*)&hist[e1], 1u);
            LAS unsigned* rp = rec + (size_t)(gb + F.tid - rbeg) * 4;
            rp[0] = (unsigned)e0 | (x0 << 8); rp[1] = (unsigned)e1 | (x1 << 8); rp[2] = __float_as_uint(w0); rp[3] = __float_as_uint(w1);
        }
    }
    __syncthreads();
    if (!commit) return;
    unsigned* cnt = (unsigned*)(F.ws + WS_CTL) + CW_CNT + layer * NE;
    if (F.tid < NE) base[F.tid] = hist[F.tid] ? atomicAdd(&cnt[F.tid], hist[F.tid]) : 0u;
    __syncthreads();
    int* tok = (int*)(F.ws + WS_TOK); u32x4* slot = (u32x4*)(F.ws + WS_SLOT);
    for (int i = F.tid; i < rend - rbeg; i += 512) {
        const LAS unsigned* rp = rec + (size_t)i * 4; const unsigned a = rp[0], b = rp[1];
        const unsigned e0 = a & 0xffu, e1 = b & 0xffu, p0 = base[e0] + (a >> 8), p1 = base[e1] + (b >> 8);
        tok[(size_t)e0 * TOKCAP + p0] = rbeg + i; tok[(size_t)e1 * TOKCAP + p1] = rbeg + i;
        u32x4 s; s.x = (e0 << 20) | p0; s.y = (e1 << 20) | p1; s.z = rp[2]; s.w = rp[3];
        slot[rbeg + i] = s;
    }
    __syncthreads();
}

__global__ void __launch_bounds__(512, 2) hymba_fwd(Args args) {
    extern __shared__ __attribute__((aligned(16))) unsigned char lds_raw[];
    Frame F;
    F.lds = (LAS unsigned char*)lds_raw;
    F.tid = threadIdx.x; F.lane = F.tid & 63; F.wave = __builtin_amdgcn_readfirstlane(F.tid >> 6);
    F.G = gridDim.x; { const int bx = blockIdx.x; F.vcu = (F.G % 8 == 0) ? (bx % 8) * (F.G / 8) + bx / 8 : bx; }
    F.in = args.in; F.out = args.out; F.ws = args.ws;
    for (int u = F.tid; u < 256; u += 512) ((LAS unsigned*)(F.lds + LDS_MISC))[u] = 0u;
    __syncthreads();
    const int lo = args.ph_lo, hi = args.ph_hi;
    XcdBarrier bar; bar.bar = (unsigned*)(F.ws + WS_CTL) + CW_BAR; bar.x = 0; bar.st = nullptr;
    if (hi - lo > 1) bar = xcd_barrier_post((unsigned*)(F.ws + WS_CTL) + CW_BAR, (volatile LAS unsigned*)(F.lds + LDS_MISC));
#ifndef ONLY_PH
#define ONLY_PH -1
#endif
#define IN(k) (lo <= (k) && (k) < hi)
#ifndef SKIP_MASK
#define SKIP_MASK 0
#endif
#define INL(j) ((ONLY_PH < 0 || ONLY_PH == 1 + (j)) && !((SKIP_MASK >> (1 + (j))) & 1) && IN(g0 + (j)))
#define SEAM(k) do { if ((k) + 1 < hi) xcd_barrier(bar); } while (0)
    bf16_t* const Hb = (bf16_t*)(F.ws + WS_H); bf16_t* const Pb = (bf16_t*)(F.ws + WS_PROJ); bf16_t* const Ab = (bf16_t*)(F.ws + WS_ACT);
    float* const XC = (float*)(F.ws + WS_XC); const float* const modp = (const float*)(F.ws + WS_MOD);
    const LAS int* tstart = (const LAS int*)(F.lds + LDS_MISC) + 16;

    if ((ONLY_PH < 0 || ONLY_PH == 0) && !(SKIP_MASK & 1) && IN(0)) { p0_prologue(F); if (REP_MASK & 1) { __syncthreads(); p0_prologue(F); } SEAM(0); }
#pragma unroll 1
    for (int layer = 0; layer < DEPTH; ++layer) {
        const int g0 = 1 + NPH_LAYER * layer;
        const bool with_ctx = layer < DEPTH - 1;
        const int nrows = with_ctx ? MT : NLAT;
        if (INL(0)) { if ((REP_MASK & 2048) && layer > 0) { p_norm<0>(F, layer, layer - 1, MT, true); __syncthreads(); } p_norm<0>(F, layer, layer - 1, MT); if ((REP_MASK & 256) && layer == 0) p_norm<0>(F, layer, layer - 1, MT); SEAM(g0 + 0); }
        if (INL(1)) {
            pg8::DenseOrder S; S.init(Hb, (const bf16_t*)(F.ws + WS_WIN) + (size_t)layer * DIN * D, MT, DIN, D, F.G, (int)blockIdx.x);
            pg8::EpiProj E{Pb, (const float*)(F.ws + WS_ROPE), F.in[I_QG] + layer * HD, F.in[I_KG] + layer * HD};
            pg8::gemm_phase<pg8::EpiProj, pg8::DenseOrder, false, true>(F.lds, D, S, E);
            if (REP_MASK & 2) pg8::gemm_phase<pg8::EpiProj, pg8::DenseOrder, false, true>(F.lds, D, S, E);
            SEAM(g0 + 1);
        }
        if (INL(2)) { p4_mixers(F, layer); SEAM(g0 + 2); }
        if (INL(3)) {
            pg8::DenseOrder S; S.init(Hb, (const bf16_t*)(F.ws + WS_WOUT) + (size_t)layer * D * DMIX, nrows, D, DMIX, F.G, (int)blockIdx.x);
            pg8::EpiResid E{layer == 0 ? F.in[I_X] : F.out, layer == 0 ? F.in[I_CTX] : XC, F.out, XC, modp + (size_t)layer * 33 * (NMOD * D) + 2 * D};
            pg8::gemm_phase<pg8::EpiResid, pg8::DenseOrder, false, true>(F.lds, DMIX, S, E);
            if ((REP_MASK & 128) && layer == 0) pg8::gemm_phase<pg8::EpiResid, pg8::DenseOrder, false, true>(F.lds, DMIX, S, E);
            SEAM(g0 + 3);
        }
        if (INL(4)) { if (REP_MASK & 512) { p6_router(F, layer, nrows, false); __syncthreads(); } p6_router(F, layer, nrows); SEAM(g0 + 4); }
        if (INL(5)) {
            build_tstart(F, layer);
            pg8::MoeOrder S{Hb, (const bf16_t*)(F.ws + WS_WGU) + (size_t)layer * NE * 1024 * 1024, (size_t)1024 * 1024, D, 4, tstart, F.G, (int)blockIdx.x,
                            (const int*)(F.ws + WS_TOK), (const int*)((const unsigned*)(F.ws + WS_CTL) + CW_CNT + layer * NE)};
            pg8::EpiGlu E{Ab};
            pg8::gemm_phase<pg8::EpiGlu, pg8::MoeOrder, true, true>(F.lds, D, S, E);
            if (REP_MASK & 32) pg8::gemm_phase<pg8::EpiGlu, pg8::MoeOrder, true, true>(F.lds, D, S, E);
            SEAM(g0 + 5);
        }
        if (INL(6)) {
            build_tstart(F, layer);
            pg8::MoeOrder S{Ab, (const bf16_t*)(F.ws + WS_WD) + (size_t)layer * NE * 1024 * DE, (size_t)1024 * DE, DE, 4, tstart, F.G, (int)blockIdx.x, nullptr, nullptr};
            pg8::EpiBf16 E{Pb, D};
            pg8::gemm_phase<pg8::EpiBf16, pg8::MoeOrder, false, true>(F.lds, DE, S, E);
            if (REP_MASK & 64) pg8::gemm_phase<pg8::EpiBf16, pg8::MoeOrder, false, true>(F.lds, DE, S, E);
            SEAM(g0 + 6);
        }
    }
    if ((ONLY_PH < 0 || ONLY_PH == 8) && !((SKIP_MASK >> 8) & 1) && IN(PH_FINAL)) { p_norm<1>(F, 0, DEPTH - 1, NLAT); }
#undef IN
#undef INL
#undef SEAM
}

extern "C" void kernel_launch(void* const* d_in, const int* in_sizes, int n_in, void* d_out, int out_size, void* d_ws, size_t ws_size, hipStream_t stream) {
    static int grid = 0;
    if (grid == 0) {
        if (n_in != N_IN || out_size != NLAT * D || ws_size < WS_END) { fprintf(stderr, "kernel_launch: unexpected shapes (n_in %d out %d ws %zu); nothing launched\n", n_in, out_size, ws_size); grid = -1; return; }
        int dev = 0, cus = 0;
        if (hipGetDevice(&dev) != hipSuccess || hipDeviceGetAttribute(&cus, hipDeviceAttributeMultiprocessorCount, dev) != hipSuccess) { grid = -1; return; }
        if (hipFuncSetAttribute((const void*)hymba_fwd, hipFuncAttributeMaxDynamicSharedMemorySize, LDS_BYTES) != hipSuccess) { fprintf(stderr, "kernel_launch: hipFuncSetAttribute failed\n"); grid = -1; return; }
        int per_cu = 0;
        if (hipOccupancyMaxActiveBlocksPerMultiprocessor(&per_cu, (const void*)hymba_fwd, 512, LDS_BYTES) != hipSuccess || per_cu < 1) { fprintf(stderr, "kernel_launch: occupancy query says %d\n", per_cu); }
        (void)hipGetLastError();
        grid = cus;
    }
    if (grid < 0) return;
    (void)hipMemsetAsync((char*)d_ws + WS_CTL, 0, CTL_ZERO_BYTES, stream);
    Args a{};
    for (int i = 0; i < N_IN; ++i) a.in[i] = (const float*)d_in[i];
    a.out = (float*)d_out; a.ws = (unsigned char*)d_ws;
#if MK_ONE_LAUNCH
    a.ph_lo = 0; a.ph_hi = NPHASES;
    hipLaunchKernelGGL(hymba_fwd, dim3(grid), dim3(512), LDS_BYTES, stream, a);
#else
    for (int p = 0; p < NPHASES; ++p) { a.ph_lo = p; a.ph_hi = p + 1; hipLaunchKernelGGL(hymba_fwd, dim3(grid), dim3(512), LDS_BYTES, stream, a); }
#endif
}
```

```cpp
#include <hip/hip_runtime.h>
#include <cstdint>
#include <cstdio>

#ifndef REP_MASK
#define REP_MASK 0
#endif
#ifndef MK_ONE_LAUNCH
#define MK_ONE_LAUNCH 1
#endif

#define LAS __attribute__((address_space(3)))
#define GAS __attribute__((address_space(1)))
typedef unsigned short bf16_t;
typedef short bf16x8 __attribute__((ext_vector_type(8)));
typedef short s16x4 __attribute__((ext_vector_type(4)));
typedef float f32x4 __attribute__((ext_vector_type(4)));
typedef float f32x2 __attribute__((ext_vector_type(2)));
typedef float f32x16 __attribute__((ext_vector_type(16)));
typedef unsigned u32x4 __attribute__((ext_vector_type(4)));
typedef unsigned u32x2 __attribute__((ext_vector_type(2)));

constexpr int D = 1024, BATCH = 32, SEQ = 2048, DEPTH = 4, CTXL = 256, HD = 64;
constexpr int NLAT = BATCH * SEQ, NCTX = BATCH * CTXL, MT = NLAT + NCTX;
constexpr int DIN = 1792, DMIX = 1024, NMOD = 6;
constexpr int PP = 1536;
constexpr int C_AQ = 0, C_AK = 384, C_CQ = 512, C_CK = 896, C_AV = 1024, C_CV = 1152, C_BU = 1280;
constexpr int O_A = 0, O_B = 384, O_C = 640;
constexpr int NE = 32, DE = 512, CONVW = 31, BCH = 256;
constexpr int TOKCAP = MT;
constexpr int NP_MAX = (2 * MT / 256 + NE) * 256;
constexpr float EPS = 1e-6f;
constexpr float LOG2E = 1.4426950408889634f;
constexpr float QSCALE = 0.125f * LOG2E;

constexpr size_t MiB = 1u << 20;
constexpr size_t WS_CTL = 0, CTL_ZERO_BYTES = 1 * MiB;
constexpr size_t WS_ROPE = 1 * MiB;
constexpr size_t WS_MOD = 2 * MiB;
constexpr size_t WS_WIN = 6 * MiB;
constexpr size_t WS_WOUT = 20 * MiB;
constexpr size_t WS_WGU = 28 * MiB;
constexpr size_t WS_WD = 284 * MiB;
constexpr size_t WS_XC = 412 * MiB;
constexpr size_t WS_H = 444 * MiB;
constexpr size_t WS_PROJ = 588 * MiB;
constexpr size_t WS_ACT = 892 * MiB;
constexpr size_t WS_TOK = 1044 * MiB;
constexpr size_t WS_SLOT = 1053 * MiB;
constexpr size_t WS_END = 1055 * MiB;
constexpr int CW_BAR = 4096;
constexpr int CW_CNT = 16384;

constexpr int LDS_BYTES = 155648;
constexpr int LDS_REC = 147456;
constexpr int LDS_MISC = 154624;

__device__ __forceinline__ float bf2f(unsigned b) { return __uint_as_float(b << 16); }
__device__ __forceinline__ unsigned f2bf(float f) { unsigned u = __float_as_uint(f); return (u + 0x7fffu + ((u >> 16) & 1u)) >> 16; }
__device__ __forceinline__ unsigned pk2(float lo, float hi) { return f2bf(lo) | (f2bf(hi) << 16); }
__device__ __forceinline__ float wave_sum(float v) {
#pragma unroll
    for (int o = 32; o >= 1; o >>= 1) v += __shfl_xor(v, o);
    return v;
}
#define LDS_WAIT() asm volatile("s_waitcnt lgkmcnt(0)" ::: "memory")
#define VM_WAIT() asm volatile("s_waitcnt vmcnt(0)" ::: "memory")

namespace pg8 {
constexpr int BM = 256, BK = 64, HALF = 128, HTB = HALF * BK * 2, STAGE_BYTES = 8 * HTB, NXCD = 8, WGM = 8;
__host__ __device__ __forceinline__ int lds_byte(int r, int c) { const int st = (r >> 4) * 2 + (c >> 5), rr = r & 15, cc = c & 31, ob = rr * 64 + cc * 2; return st * 1024 + (ob ^ (((ob >> 9) & 1) << 5)); }
__host__ __device__ __forceinline__ void stage_rc(int b, int& R, int& C) { const int st = b / 1024, sb = b % 1024, swz = sb ^ (((sb >> 9) & 1) << 5); R = (st >> 1) * 16 + swz / 64; C = (st & 1) * 32 + (swz % 64) / 2; }
__host__ __device__ __forceinline__ int perm32(int rho) { const int n = rho >> 4, i = rho & 15; return 8 * (i >> 2) + 4 * n + (i & 3); }

struct Unit { int pm, pn, e; };

struct DenseOrder {
    const bf16_t* A; const bf16_t* Bt; int K; int nM, nN, nwg, G, c;
    __device__ void init(const bf16_t* A_, const bf16_t* Bt_, int M, int N, int K_, int G_, int c_) { A = A_; Bt = Bt_; K = K_; nM = M / BM; nN = N / BM; nwg = nM * nN; G = G_; c = c_; }
    __device__ __forceinline__ bool next(int i, Unit& u) const {
        const long L = (long)i * G + c; if (L >= nwg) return false;
        int wgid = (int)L; { const int q = nwg / NXCD, r = nwg % NXCD, xcd = wgid % NXCD, off = wgid / NXCD; wgid = (xcd < r ? xcd * (q + 1) : r * (q + 1) + (xcd - r) * q) + off; }
        const int nig = WGM * nN, gid = wgid / nig, fm = gid * WGM, gsz = (nM - fm) < WGM ? (nM - fm) : WGM;
        u.pm = fm + ((wgid % nig) % gsz); u.pn = (wgid % nig) / gsz; u.e = 0; return true;
    }
    __device__ __forceinline__ const char* a_base(const Unit& u) const { return (const char*)A + (size_t)u.pm * BM * K * 2; }
    __device__ __forceinline__ const char* b_base(const Unit& u) const { return (const char*)Bt + (size_t)u.pn * BM * K * 2; }
    __device__ __forceinline__ unsigned row_off(const Unit&, int) const { return 0u; }
};
struct MoeOrder {
    const bf16_t* A; const bf16_t* W; size_t wstride; int K; int ncol; const LAS int* tstart; int G, c;
    const int* tok; const int* cnt;
    __device__ __forceinline__ bool next(int i, Unit& u) const {
        const long L = (long)i * G + c; const int nt = tstart[NE];
        if (L >= (long)nt * ncol) return false;
        u.pm = (int)(L / ncol); u.pn = (int)(L % ncol);
        int e = 0;
#pragma unroll 1
        for (; e < NE - 1; ++e) if (tstart[e + 1] > u.pm) break;
        u.e = e; return true;
    }
    __device__ __forceinline__ const char* a_base(const Unit& u) const { return (const char*)A + (tok ? (size_t)0 : (size_t)u.pm * BM * K * 2); }
    __device__ __forceinline__ const char* b_base(const Unit& u) const { return (const char*)W + ((size_t)u.e * wstride + (size_t)u.pn * BM * K) * 2; }
    __device__ __forceinline__ unsigned row_off(const Unit& u, int r) const {
        const int n = cnt[u.e]; int p = (u.pm - tstart[u.e]) * BM + r; p = p < n ? p : n - 1;
        return (unsigned)tok[(size_t)u.e * TOKCAP + p] * (unsigned)(K * 2);
    }
};

__device__ __forceinline__ unsigned cvt_pk_bf16(float lo, float hi) { unsigned r; asm volatile("v_cvt_pk_bf16_f32 %0, %1, %2" : "=v"(r) : "v"(lo), "v"(hi)); return r; }

struct EpiBf16 {
    static constexpr bool PERM = true;
    bf16_t* O; int ldc;
    __device__ __forceinline__ void operator()(const f32x4 (&acc)[2][2][4][2], const Unit& u, int wr, int wc, int fr, int fq) const {
        const int row0 = u.pm * BM + wr * 64 + fr, col0 = u.pn * BM + wc * 32 + 8 * fq;
#pragma unroll
        for (int ai = 0; ai < 2; ++ai)
#pragma unroll
            for (int m = 0; m < 4; ++m) { bf16_t* rowp = O + (size_t)(row0 + ai * HALF + m * 16) * ldc + col0;
#pragma unroll
                for (int bj = 0; bj < 2; ++bj) { const f32x4 v0 = acc[ai][bj][m][0], v1 = acc[ai][bj][m][1];
                    u32x4 w; w.x = cvt_pk_bf16(v0[0], v0[1]); w.y = cvt_pk_bf16(v0[2], v0[3]); w.z = cvt_pk_bf16(v1[0], v1[1]); w.w = cvt_pk_bf16(v1[2], v1[3]);
                    *(u32x4*)(rowp + bj * HALF) = w; } }
    }
};
struct EpiProj {
    static constexpr bool PERM = true;
    bf16_t* O; const float* rope; const float* qg; const float* kg;
    __device__ __forceinline__ void operator()(const f32x4 (&acc)[2][2][4][2], const Unit& u, int wr, int wc, int fr, int fq) const {
        const int row0 = u.pm * BM + wr * 64 + fr;
        if (u.pn == 4) {
            const int col0 = C_AV + wc * 32 + 8 * fq;
#pragma unroll
            for (int ai = 0; ai < 2; ++ai)
#pragma unroll
                for (int m = 0; m < 4; ++m) { bf16_t* rowp = O + (size_t)(row0 + ai * HALF + m * 16) * PP + col0;
#pragma unroll
                    for (int bj = 0; bj < 2; ++bj) { const f32x4 v0 = acc[ai][bj][m][0], v1 = acc[ai][bj][m][1];
                        u32x4 w; w.x = cvt_pk_bf16(v0[0], v0[1]); w.y = cvt_pk_bf16(v0[2], v0[3]); w.z = cvt_pk_bf16(v1[0], v1[1]); w.w = cvt_pk_bf16(v1[2], v1[3]);
                        *(u32x4*)(rowp + bj * HALF) = w; } }
        } else if (u.pn >= 5) {
            const int col0 = C_BU + (u.pn - 5) * HALF + wc * 32 + 8 * fq;
#pragma unroll
            for (int ai = 0; ai < 2; ++ai)
#pragma unroll
                for (int m = 0; m < 4; ++m) { bf16_t* rowp = O + (size_t)(row0 + ai * HALF + m * 16) * PP + col0;
                    float r[8];
#pragma unroll
                    for (int n = 0; n < 2; ++n)
#pragma unroll
                        for (int i = 0; i < 4; ++i) { const float a = acc[ai][0][m][n][i], g = acc[ai][1][m][n][i];
                            r[n * 4 + i] = a * __builtin_amdgcn_rcpf(1.0f + __builtin_amdgcn_exp2f(-g * LOG2E)); }
                    u32x4 w; w.x = cvt_pk_bf16(r[0], r[1]); w.y = cvt_pk_bf16(r[2], r[3]); w.z = cvt_pk_bf16(r[4], r[5]); w.w = cvt_pk_bf16(r[6], r[7]);
                    *(u32x4*)rowp = w; }
        } else {
            const bool isA = u.pn < 2, isq = ((u.pn & 1) == 0) || (wc < 2), lat = u.pm < NLAT / BM;
            const float* gp = isq ? qg : kg;
            f32x4 gn[2][2];
#pragma unroll
            for (int a = 0; a < 2; ++a)
#pragma unroll
                for (int t = 0; t < 2; ++t) gn[a][t] = *(const f32x4*)(gp + 32 * a + 16 * t + 4 * fq);
            const float qs = isq ? QSCALE : 1.0f;
            const int col0 = u.pn * BM + wc * 64 + 8 * fq;
#pragma unroll
            for (int ai = 0; ai < 2; ++ai)
#pragma unroll
                for (int m = 0; m < 4; ++m) {
                    const int row = row0 + ai * HALF + m * 16;
                    f32x4 v[2][2];
#pragma unroll
                    for (int a = 0; a < 2; ++a)
#pragma unroll
                        for (int t = 0; t < 2; ++t) v[a][t] = acc[ai][a][m][t];
                    if (isA) {
                        float ss = 0.f;
#pragma unroll
                        for (int a = 0; a < 2; ++a)
#pragma unroll
                            for (int t = 0; t < 2; ++t) ss += (v[a][t][0] * v[a][t][0] + v[a][t][1] * v[a][t][1]) + (v[a][t][2] * v[a][t][2] + v[a][t][3] * v[a][t][3]);
                        ss += __shfl_xor(ss, 16); ss += __shfl_xor(ss, 32);
                        const float rstd = 1.0f / sqrtf(ss * (1.0f / HD) + EPS);
#pragma unroll
                        for (int a = 0; a < 2; ++a)
#pragma unroll
                            for (int t = 0; t < 2; ++t) v[a][t] = v[a][t] * rstd * gn[a][t];
                    }
                    if (lat) {
                        const int s = row & (SEQ - 1);
#pragma unroll
                        for (int a = 0; a < 2; ++a) { const int pos = a == 0 ? (s >> 6) : (s & 63);
                            const f32x4 cs = *(const f32x4*)(rope + pos * 16 + 4 * fq), sn = *(const f32x4*)(rope + 1024 + pos * 16 + 4 * fq);
                            const f32x4 x1 = v[a][0], x2 = v[a][1];
                            v[a][0] = x1 * cs - x2 * sn; v[a][1] = x2 * cs + x1 * sn; }
                    }
                    bf16_t* rowp = O + (size_t)row * PP + col0;
#pragma unroll
                    for (int a = 0; a < 2; ++a) { const f32x4 p = v[a][0] * qs, q = v[a][1] * qs;
                        u32x4 w; w.x = cvt_pk_bf16(p[0], p[1]); w.y = cvt_pk_bf16(p[2], p[3]); w.z = cvt_pk_bf16(q[0], q[1]); w.w = cvt_pk_bf16(q[2], q[3]);
                        *(u32x4*)(rowp + 32 * a) = w; }
                }
        }
    }
};
struct EpiGlu {
    static constexpr bool PERM = true;
    bf16_t* O;
    __device__ __forceinline__ void operator()(const f32x4 (&acc)[2][2][4][2], const Unit& u, int wr, int wc, int fr, int fq) const {
        const int row0 = u.pm * BM + wr * 64 + fr, col0 = u.pn * HALF + wc * 32 + 8 * fq;
#pragma unroll
        for (int ai = 0; ai < 2; ++ai)
#pragma unroll
            for (int m = 0; m < 4; ++m) { bf16_t* rowp = O + (size_t)(row0 + ai * HALF + m * 16) * DE + col0;
                float r[8];
#pragma unroll
                for (int n = 0; n < 2; ++n)
#pragma unroll
                    for (int i = 0; i < 4; ++i) { const float g = acc[ai][0][m][n][i], up = acc[ai][1][m][n][i];
                        r[n * 4 + i] = g * __builtin_amdgcn_rcpf(1.0f + __builtin_amdgcn_exp2f(-g * LOG2E)) * up; }
                u32x4 w; w.x = cvt_pk_bf16(r[0], r[1]); w.y = cvt_pk_bf16(r[2], r[3]); w.z = cvt_pk_bf16(r[4], r[5]); w.w = cvt_pk_bf16(r[6], r[7]);
                *(u32x4*)rowp = w; }
    }
};
struct EpiResid {
    static constexpr bool PERM = false;
    const float* xin_lat; const float* xin_ctx; float* xout_lat; float* xout_ctx; const float* gate;
    __device__ __forceinline__ void operator()(const f32x4 (&acc)[2][2][4][2], const Unit& u, int wr, int wc, int fr, int fq) const {
        const int col0 = u.pn * BM + wc * 32 + 4 * fq;
        const bool lat = u.pm < NLAT / BM;
        const int mrow = lat ? (u.pm >> 3) : BATCH;
        const size_t rbase = lat ? (size_t)u.pm * BM : (size_t)u.pm * BM - NLAT;
        const float* xin = lat ? xin_lat : xin_ctx; float* xout = lat ? xout_lat : xout_ctx;
        f32x4 gv[2][2];
#pragma unroll
        for (int bj = 0; bj < 2; ++bj)
#pragma unroll
            for (int n = 0; n < 2; ++n) gv[bj][n] = *(const f32x4*)(gate + (size_t)mrow * (NMOD * D) + col0 + bj * HALF + n * 16);
#pragma unroll
        for (int ai = 0; ai < 2; ++ai)
#pragma unroll
            for (int m = 0; m < 4; ++m) { const size_t off = (rbase + ai * HALF + wr * 64 + m * 16 + fr) * D + col0;
#pragma unroll
                for (int bj = 0; bj < 2; ++bj)
#pragma unroll
                    for (int n = 0; n < 2; ++n) { const f32x4 xi = *(const f32x4*)(xin + off + bj * HALF + n * 16);
                        *(f32x4*)(xout + off + bj * HALF + n * 16) = xi + gv[bj][n] * acc[ai][bj][m][n]; } }
    }
};

template <class Epi, class Sched, bool GATHER, bool ALIGN_EPI>
__device__ __forceinline__ void gemm_phase(LAS unsigned char* lds, const int K, const Sched& S, const Epi& E) {
    int tid = threadIdx.x; asm volatile("" : "+v"(tid));
    const int wid = __builtin_amdgcn_readfirstlane(tid >> 6), lane = tid & 63, wr = wid >> 2, wc = wid & 3, fr = lane & 15, fq = lane >> 4;
    const int nt = K / BK;
    unsigned voffA[2], voffB[2]; int sR[2], sC2[2];
#pragma unroll
    for (int i = 0; i < 2; ++i) { int R, C; stage_rc(tid * 16 + i * 8192, R, C); const int Rb = Epi::PERM ? ((R & ~31) + perm32(R & 31)) : R;
        voffA[i] = (unsigned)(R * K + C) * 2u; voffB[i] = (unsigned)(Rb * K + C) * 2u; sR[i] = R; sC2[i] = C * 2; }
    const size_t kstep = (size_t)(BK * 2);
    const size_t hstep = (size_t)HALF * K * 2;
    const unsigned ldsw = (unsigned)wid * 1024u;
    const int aoff = lds_byte(wr * 64 + fr, fq * 8), boff = lds_byte(wc * 32 + fr, fq * 8);
#define PG8_SA(b, h) (((b) * 2 + (h)) * HTB)
#define PG8_SB(b, h) ((4 + (b) * 2 + (h)) * HTB)
#define PG8_STAGE(bufoff, gbase, voff) do { _Pragma("unroll") for (int _i = 0; _i < 2; ++_i) \
        __builtin_amdgcn_global_load_lds((const unsigned*)((const char*)(gbase) + (voff)[_i]), (LAS unsigned*)(lds + (bufoff) + ldsw + _i * 8192), 16, 0, 0); } while (0)
#define PG8_STAGE_A(bufoff, kp, h, O0, O1) do { if constexpr (GATHER) { if ((h) == 0) PG8_STAGE(bufoff, kp, O0); else PG8_STAGE(bufoff, kp, O1); } else { PG8_STAGE(bufoff, (kp) + (h) * hstep, voffA); } } while (0)
#define PG8_LDA(dst, b, h) do { _Pragma("unroll") for (int m = 0; m < 4; ++m) _Pragma("unroll") for (int k = 0; k < 2; ++k) dst[m][k] = *(const LAS bf16x8*)(lds + PG8_SA(b, h) + aoff + m * 2048 + k * 1024); } while (0)
#define PG8_LDB(dst, b, h) do { _Pragma("unroll") for (int n = 0; n < 2; ++n) _Pragma("unroll") for (int k = 0; k < 2; ++k) dst[n][k] = *(const LAS bf16x8*)(lds + PG8_SB(b, h) + boff + n * 2048 + k * 1024); } while (0)
#define PG8_MMA(ai, bj, At, Bt) do { __builtin_amdgcn_s_setprio(1); _Pragma("unroll") for (int m = 0; m < 4; ++m) _Pragma("unroll") for (int n = 0; n < 2; ++n) _Pragma("unroll") for (int k = 0; k < 2; ++k) \
        acc[ai][bj][m][n] = __builtin_amdgcn_mfma_f32_16x16x32_bf16(Bt[n][k], At[m][k], acc[ai][bj][m][n], 0, 0, 0); __builtin_amdgcn_s_setprio(0); } while (0)
#define PG8_WAIT_V(n) asm volatile("s_waitcnt vmcnt(" #n ")" ::: "memory")
#define PG8_WAIT_L(n) asm volatile("s_waitcnt lgkmcnt(" #n ")" ::: "memory")
#define PG8_BAR __builtin_amdgcn_s_barrier()
#define PG8_SCHED __builtin_amdgcn_sched_barrier(0)
    Unit cur, nxt; int ui = 0;
    if (!S.next(0, cur)) return;
    f32x4 acc[2][2][4][2];
#pragma unroll
    for (int a = 0; a < 2; ++a)
#pragma unroll
        for (int b = 0; b < 2; ++b)
#pragma unroll
            for (int m = 0; m < 4; ++m)
#pragma unroll
                for (int n = 0; n < 2; ++n) acc[a][b][m][n] = (f32x4){0.f, 0.f, 0.f, 0.f};
    bf16x8 At[4][2], B0[2][2], B1[2][2];
    const char* cA = S.a_base(cur); const char* cB = S.b_base(cur);
    unsigned ca0[2] = {0u, 0u}, ca1[2] = {0u, 0u}, na0[2] = {0u, 0u}, na1[2] = {0u, 0u};
    if constexpr (GATHER) {
#pragma unroll
        for (int i = 0; i < 2; ++i) { ca0[i] = S.row_off(cur, sR[i]) + (unsigned)sC2[i]; ca1[i] = S.row_off(cur, HALF + sR[i]) + (unsigned)sC2[i]; }
    }
    PG8_STAGE(PG8_SB(0, 0), cB, voffB); PG8_STAGE(PG8_SB(0, 1), cB + hstep, voffB); PG8_STAGE_A(PG8_SA(0, 0), cA, 0, ca0, ca1); PG8_STAGE_A(PG8_SA(0, 1), cA, 1, ca0, ca1);
    if (wr == 1) PG8_BAR;
    PG8_WAIT_V(2); PG8_BAR;
    PG8_STAGE(PG8_SB(1, 0), cB + kstep, voffB); PG8_STAGE_A(PG8_SA(1, 0), cA + kstep, 0, ca0, ca1); PG8_STAGE(PG8_SB(1, 1), cB + hstep + kstep, voffB);
    PG8_WAIT_V(6); PG8_BAR;
    for (;;) {
        const bool has_next = S.next(ui + 1, nxt);
        const char* nA = has_next ? S.a_base(nxt) : cA; const char* nB = has_next ? S.b_base(nxt) : cB;
        if constexpr (GATHER) {
            if (has_next) {
#pragma unroll
                for (int i = 0; i < 2; ++i) { na0[i] = S.row_off(nxt, sR[i]) + (unsigned)sC2[i]; na1[i] = S.row_off(nxt, HALF + sR[i]) + (unsigned)sC2[i]; }
            } else { na0[0] = ca0[0]; na0[1] = ca0[1]; na1[0] = ca1[0]; na1[1] = ca1[1]; }
        }
        for (int t = 0; t < nt; t += 2) {
            const bool last = (t == nt - 2);
            const char* a1 = cA + (size_t)(t + 1) * kstep;
            const char* a2 = last ? nA : cA + (size_t)(t + 2) * kstep; const char* b2 = last ? nB : cB + (size_t)(t + 2) * kstep;
            const char* a3 = a2 + kstep; const char* b3 = b2 + kstep;
            unsigned x0[2], x1[2];
            x0[0] = last ? na0[0] : ca0[0]; x0[1] = last ? na0[1] : ca0[1]; x1[0] = last ? na1[0] : ca1[0]; x1[1] = last ? na1[1] : ca1[1];
            PG8_LDB(B0, 0, 0); PG8_LDB(B1, 0, 1); PG8_SCHED; PG8_LDA(At, 0, 0); PG8_STAGE_A(PG8_SA(1, 1), a1, 1, ca0, ca1);
            PG8_WAIT_V(8); PG8_WAIT_L(0); PG8_BAR; PG8_MMA(0, 0, At, B0); PG8_MMA(0, 1, At, B1); PG8_BAR; PG8_SCHED;
            PG8_LDA(At, 0, 1); PG8_STAGE(PG8_SB(0, 0), b2, voffB); PG8_STAGE(PG8_SB(0, 1), b2 + hstep, voffB); PG8_STAGE_A(PG8_SA(0, 0), a2, 0, x0, x1);
            PG8_WAIT_V(8); PG8_WAIT_L(0); PG8_BAR; PG8_MMA(1, 0, At, B0); PG8_MMA(1, 1, At, B1); PG8_BAR; PG8_SCHED;
            PG8_LDB(B0, 1, 0); PG8_LDB(B1, 1, 1); PG8_SCHED; PG8_LDA(At, 1, 0); PG8_STAGE_A(PG8_SA(0, 1), a2, 1, x0, x1);
            PG8_WAIT_V(8); PG8_WAIT_L(0); PG8_BAR; PG8_MMA(0, 0, At, B0); PG8_MMA(0, 1, At, B1); PG8_BAR; PG8_SCHED;
            PG8_LDA(At, 1, 1); PG8_STAGE(PG8_SB(1, 0), b3, voffB); PG8_STAGE(PG8_SB(1, 1), b3 + hstep, voffB); PG8_STAGE_A(PG8_SA(1, 0), a3, 0, x0, x1);
            PG8_WAIT_V(8); PG8_WAIT_L(0); PG8_BAR; PG8_MMA(1, 0, At, B0); PG8_MMA(1, 1, At, B1); PG8_BAR; PG8_SCHED;
        }
        if constexpr (ALIGN_EPI) { if (wr == 0) PG8_BAR; }
        E(acc, cur, wr, wc, fr, fq);
        if (!has_next) break;
#pragma unroll
        for (int a = 0; a < 2; ++a)
#pragma unroll
            for (int b = 0; b < 2; ++b)
#pragma unroll
                for (int m = 0; m < 4; ++m)
#pragma unroll
                    for (int n = 0; n < 2; ++n) acc[a][b][m][n] = (f32x4){0.f, 0.f, 0.f, 0.f};
        cur = nxt; cA = nA; cB = nB; ++ui;
        if constexpr (GATHER) { ca0[0] = na0[0]; ca0[1] = na0[1]; ca1[0] = na1[0]; ca1[1] = na1[1]; }
        if constexpr (ALIGN_EPI) { if (wr == 1) PG8_BAR; }
    }
    PG8_WAIT_V(0);
    if constexpr (!ALIGN_EPI) { if (wr == 0) PG8_BAR; }
    PG8_BAR;
#undef PG8_SA
#undef PG8_SB
#undef PG8_STAGE
#undef PG8_STAGE_A
#undef PG8_LDA
#undef PG8_LDB
#undef PG8_MMA
#undef PG8_WAIT_V
#undef PG8_WAIT_L
#undef PG8_BAR
#undef PG8_SCHED
}
}

#define XB_TMO      128
#define XB_XCNT(j)  (256  + 64 * (j))
#define XB_XSUB(j)  (1280 + 64 * (j))
#define XB_XGEN(j)  (2304 + 64 * (j))
#define XB_TOP      3328
#define XB_TOPGEN   3392
#define XCD_BAR_WORDS 3456
#define XB_SPIN_CAP (1u << 22)
__device__ __forceinline__ unsigned xb_ld(unsigned* p)              { return __hip_atomic_load(p, __ATOMIC_RELAXED, __HIP_MEMORY_SCOPE_AGENT); }
__device__ __forceinline__ unsigned xb_add(unsigned* p, unsigned v) { return __hip_atomic_fetch_add(p, v, __ATOMIC_RELAXED, __HIP_MEMORY_SCOPE_AGENT); }
__device__ __forceinline__ unsigned xb_xcc_id() { return (unsigned)__builtin_amdgcn_s_getreg((3 << 11) | 20) & 0xFu; }
#define XB_SPIN(cond, bar) do { unsigned _sp = 0; while (cond) { __builtin_amdgcn_s_sleep(1); \
    if ((++_sp & 255u) == 0u) { if (xb_ld(&(bar)[XB_TMO])) break; if (_sp > XB_SPIN_CAP) { atomicAdd(&(bar)[XB_TMO], 1u); break; } } } } while (0)
struct XcdBarrier { unsigned* bar; unsigned x; volatile LAS unsigned* st; };
__device__ __forceinline__ XcdBarrier xcd_barrier_post(unsigned* bar, volatile LAS unsigned* st) {
    XcdBarrier b; b.bar = bar; b.x = xb_xcc_id(); b.st = st;
    if (threadIdx.x == 0) (void)xb_add(&bar[XB_XCNT(b.x)], 1u);
    return b;
}
__device__ __forceinline__ void xcd_barrier_complete(unsigned* bar, unsigned x, unsigned& nloc, unsigned& nx) {
    const unsigned G = gridDim.x * gridDim.y * gridDim.z;
    unsigned sum, cnt, mine, sp = 0u;
    for (;;) {
        sum = 0u; cnt = 0u; mine = 0u;
#pragma unroll
        for (unsigned j = 0; j < 16; ++j) { const unsigned c = xb_ld(&bar[XB_XCNT(j)]); sum += c; cnt += (c > 0u) ? 1u : 0u; mine = (j == x) ? c : mine; }
        if (sum == G) break;
        __builtin_amdgcn_s_sleep(1);
        if ((++sp & 255u) == 0u) { if (xb_ld(&bar[XB_TMO])) break; if (sp > XB_SPIN_CAP) { atomicAdd(&bar[XB_TMO], 1u); break; } }
    }
    nloc = mine > 0u ? mine : 1u; nx = cnt > 0u ? cnt : 1u;
}
__device__ __forceinline__ void xcd_barrier(const XcdBarrier& b) {
    asm volatile("s_waitcnt vmcnt(0)" ::: "memory");
    __syncthreads();
    if (threadIdx.x == 0) {
        unsigned* bar = b.bar;
        __builtin_amdgcn_s_waitcnt(0);
        unsigned nloc = b.st[0], nx = b.st[1];
        if (nloc == 0u) { xcd_barrier_complete(bar, b.x, nloc, nx); b.st[0] = nloc; b.st[1] = nx; }
        const unsigned old = xb_add(&bar[XB_XSUB(b.x)], 1u);
        const unsigned gen = old / nloc;
        if (old + 1u == (gen + 1u) * nloc) {
            __builtin_amdgcn_fence(__ATOMIC_RELEASE, "agent");
            asm volatile("s_waitcnt vmcnt(0)" ::: "memory");
            const unsigned og = xb_add(&bar[XB_TOP], 1u);
            const unsigned tg = og / nx;
            if (og + 1u == (tg + 1u) * nx) xb_add(&bar[XB_TOPGEN], 1u);
            else XB_SPIN(xb_ld(&bar[XB_TOPGEN]) == tg, bar);
            __builtin_amdgcn_fence(__ATOMIC_ACQUIRE, "agent");
            xb_add(&bar[XB_XGEN(b.x)], 1u);
            asm volatile("s_waitcnt vmcnt(0)" ::: "memory");
        } else {
            XB_SPIN(xb_ld(&bar[XB_XGEN(b.x)]) == gen, bar);
            __builtin_amdgcn_fence(__ATOMIC_ACQUIRE, "agent");
            asm volatile("s_waitcnt vmcnt(0)" ::: "memory");
        }
    }
    __syncthreads();
}

enum { I_X = 0, I_C, I_CTX, I_CCTX, I_N1G, I_N2G, I_WMOD, I_BMOD, I_WIN, I_QG, I_KG, I_CONVW, I_CONVB, I_LNG, I_LNB, I_SINK, I_WOUT, I_WGRP, I_BGRP, I_WEXP, I_BEXP, I_WGATE, I_WUP, I_WDOWN, I_FING, N_IN };
struct Args { const float* in[N_IN]; float* out; unsigned char* ws; int ph_lo, ph_hi; };
struct Frame {
    LAS unsigned char* lds;
    int tid, lane, wave, G, vcu;
    const float* const* in; float* out; unsigned char* ws;
};
__device__ __forceinline__ void frame_ids(Frame& F) { int t = threadIdx.x; asm volatile("" : "+v"(t)); F.tid = t; F.lane = t & 63; F.wave = __builtin_amdgcn_readfirstlane(t >> 6); }
constexpr int NPH_LAYER = 7, PH_FINAL = 1 + NPH_LAYER * DEPTH, NPHASES = PH_FINAL + 1;

__device__ __forceinline__ int win_dest_row(int o) {
    int tile, c;
    auto cpos = [](int d, int wc) { const int a = d >> 5, t = (d >> 4) & 1, f = d & 15; return 128 * a + 32 * wc + 8 * (f >> 2) + 4 * t + (f & 3); };
    if (o < 384) { const int h = o >> 6; tile = h >> 2; c = cpos(o & 63, h & 3); }
    else if (o < 512) { const int kh = (o - 384) >> 6; tile = 1; c = cpos(o & 63, 2 + kh); }
    else if (o < 640) { tile = 4; c = o - 512; }
    else if (o < 896) { const int j = o - 640; tile = 5 + (j >> 7); c = j & 127; }
    else if (o < 1152) { const int j = o - 896; tile = 5 + (j >> 7); c = 128 + (j & 127); }
    else if (o < 1536) { const int h = (o - 1152) >> 6; tile = 2 + (h >> 2); c = cpos(o & 63, h & 3); }
    else if (o < 1664) { const int kh = (o - 1536) >> 6; tile = 3; c = cpos(o & 63, 2 + kh); }
    else { tile = 4; c = 128 + (o - 1664); }
    return tile * 256 + c;
}
template <bool PERMW = false>
__device__ __forceinline__ void transpose_item(const float* W, int K, int N, int k0, int n0, bf16_t* dst_rows, LAS float* scr, int lane) {
#pragma unroll 8
    for (int i = 0; i < 32; ++i) { const int kk = 2 * i + (lane >> 5); scr[kk * 33 + (lane & 31)] = W[(size_t)(k0 + kk) * N + n0 + (lane & 31)]; }
    LDS_WAIT();
    const int c = lane & 7;
#pragma unroll
    for (int j = 0; j < 4; ++j) { const int n = (lane >> 3) + 8 * j; const LAS float* s = scr + (8 * c) * 33 + n;
        u32x4 o; o.x = pk2(s[0 * 33], s[1 * 33]); o.y = pk2(s[2 * 33], s[3 * 33]); o.z = pk2(s[4 * 33], s[5 * 33]); o.w = pk2(s[6 * 33], s[7 * 33]);
        const int drow = PERMW ? win_dest_row(n0 + n) : n;
        *(u32x4*)(dst_rows + (size_t)drow * K + k0 + 8 * c) = o; }
    LDS_WAIT();
}
__device__ __forceinline__ void p0_prologue(Frame& F) {
    frame_ids(F);
    LAS float* scr = (LAS float*)(F.lds + F.wave * 16384);
    const int gw = F.vcu * 8 + F.wave, NGW = F.G * 8;
    bf16_t* Win_t = (bf16_t*)(F.ws + WS_WIN); bf16_t* Wout_t = (bf16_t*)(F.ws + WS_WOUT); bf16_t* Wgu_t = (bf16_t*)(F.ws + WS_WGU); bf16_t* Wd_t = (bf16_t*)(F.ws + WS_WD);
    constexpr int T_IN = DEPTH * 16 * 56, T_OUT = DEPTH * 16 * 32, T_G = DEPTH * NE * 16 * 16, T_D = DEPTH * NE * 8 * 32;
    constexpr int NITEMS = T_IN + T_OUT + 2 * T_G + T_D;
    for (int it = gw; it < NITEMS; it += NGW) {
        int r = it;
        if (r < T_IN) { const int l = r / 896, q = r % 896, kb = q / 56, nb = q % 56;
            transpose_item<true>(F.in[I_WIN] + (size_t)l * D * DIN, D, DIN, 64 * kb, 32 * nb, Win_t + (size_t)l * DIN * D, scr, F.lane); continue; }
        r -= T_IN;
        if (r < T_OUT) { const int l = r / 512, q = r % 512, kb = q / 32, nb = q % 32;
            transpose_item(F.in[I_WOUT] + (size_t)l * DMIX * D, DMIX, D, 64 * kb, 32 * nb, Wout_t + ((size_t)l * D + 32 * nb) * DMIX, scr, F.lane); continue; }
        r -= T_OUT;
        if (r < 2 * T_G) { const int up = r >= T_G; if (up) r -= T_G; const int mat = r / 256, q = r % 256, kb = q / 16, nb = q % 16, n0 = 32 * nb;
            const int drow = 256 * (n0 / 128) + (n0 % 128) + (up ? 128 : 0);
            transpose_item(F.in[up ? I_WUP : I_WGATE] + (size_t)mat * D * DE, D, DE, 64 * kb, n0, Wgu_t + ((size_t)mat * 1024 + drow) * D, scr, F.lane); continue; }
        r -= 2 * T_G;
        { const int mat = r / 256, q = r % 256, kb = q / 32, nb = q % 32;
            transpose_item(F.in[I_WDOWN] + (size_t)mat * DE * D, DE, D, 64 * kb, 32 * nb, Wd_t + ((size_t)mat * D + 32 * nb) * DE, scr, F.lane); }
    }
    { float* rope = (float*)(F.ws + WS_ROPE); const int gt = F.vcu * 512 + F.tid;
      if (gt < 1024) { const int pos = gt >> 4, f = gt & 15; const float inv = powf(10000.0f, -(float)f / 16.0f); const float ang = (float)pos * inv; rope[gt] = cosf(ang); rope[1024 + gt] = sinf(ang); } }
    __syncthreads();
    { LAS float* sc = (LAS float*)F.lds;
      float* mod = (float*)(F.ws + WS_MOD);
      for (int un = F.vcu; un < DEPTH * 192; un += F.G) {
          const int l = un / 192, n0 = (un % 192) * 32;
          for (int idx = F.tid; idx < 33 * 1024; idx += 512) { const int r = idx >> 10, k = idx & 1023; const float v = r < 32 ? F.in[I_C][r * 1024 + k] : F.in[I_CCTX][k]; sc[idx] = v / (1.0f + __expf(-v)); }
          __syncthreads();
          const int col = F.tid & 31, kg = F.tid >> 5;
          float acc[33];
#pragma unroll
          for (int r = 0; r < 33; ++r) acc[r] = 0.f;
          const float* wp = F.in[I_WMOD] + ((size_t)l * D + kg * 64) * (NMOD * D) + n0 + col;
          for (int k = 0; k < 64; ++k) { const float w = wp[(size_t)k * (NMOD * D)];
#pragma unroll
              for (int r = 0; r < 33; ++r) acc[r] += sc[r * 1024 + kg * 64 + k] * w; }
#pragma unroll
          for (int r = 0; r < 33; ++r) acc[r] += __shfl_xor(acc[r], 32);
          __syncthreads();
          LAS float* red = (LAS float*)F.lds;
          if (F.lane < 32) {
#pragma unroll
              for (int r = 0; r < 33; ++r) red[(F.wave * 33 + r) * 32 + col] = acc[r]; }
          __syncthreads();
          for (int idx = F.tid; idx < 33 * 32; idx += 512) { const int r = idx >> 5, cc = idx & 31; float s = 0.f;
#pragma unroll
              for (int w = 0; w < 8; ++w) s += red[(w * 33 + r) * 32 + cc];
              mod[((size_t)l * 33 + r) * (NMOD * D) + n0 + cc] = s + F.in[I_BMOD][l * (NMOD * D) + n0 + cc]; }
          __syncthreads();
      }
    }
}

__device__ __forceinline__ void build_tstart(Frame& F, int layer) {
    frame_ids(F);
    LAS int* ts = (LAS int*)(F.lds + LDS_MISC) + 16;
    if (F.tid == 0) { const unsigned* cnt = (const unsigned*)(F.ws + WS_CTL) + CW_CNT + layer * NE; int s = 0;
        for (int e = 0; e < NE; ++e) { ts[e] = s; s += ((int)cnt[e] + 255) >> 8; } ts[NE] = s; }
    __syncthreads();
}
template <int MODE>
__device__ __forceinline__ void p_norm(Frame& F, int layer, int comb_layer, int nrows, bool dry = false) {
    frame_ids(F);
    const int gw = F.vcu * 8 + F.wave, NGW = F.G * 8;
    const float* mod = (const float*)(F.ws + WS_MOD);
    const bf16_t* Y = (const bf16_t*)(F.ws + WS_PROJ);
    const u32x4* slot = (const u32x4*)(F.ws + WS_SLOT);
    bf16_t* H = (bf16_t*)(F.ws + WS_H);
    const LAS int* ts = (const LAS int*)(F.lds + LDS_MISC) + 16;
    if (comb_layer >= 0) build_tstart(F, comb_layer);
    const float* gptr = MODE == 0 ? F.in[I_N1G] + layer * D : F.in[I_FING];
    f32x4 g[4];
#pragma unroll
    for (int j = 0; j < 4; ++j) g[j] = *(const f32x4*)(gptr + 4 * F.lane + 256 * j);
    for (int r = gw; r < nrows; r += NGW) {
        const bool lat = r < NLAT; const int mrow = lat ? r / SEQ : BATCH;
        const float* xin; float* xout;
        if (lat) { xout = F.out + (size_t)r * D; xin = (layer == 0 && MODE == 0) ? F.in[I_X] + (size_t)r * D : xout; }
        else { xout = (float*)(F.ws + WS_XC) + (size_t)(r - NLAT) * D; xin = (layer == 0 && MODE == 0) ? F.in[I_CTX] + (size_t)(r - NLAT) * D : xout; }
        f32x4 v[4];
#pragma unroll
        for (int j = 0; j < 4; ++j) v[j] = *(const f32x4*)(xin + 4 * F.lane + 256 * j);
        if (comb_layer >= 0) {
            const u32x4 si = slot[r];
            const int e0 = si.x >> 20, e1 = si.y >> 20;
            const size_t p0 = (size_t)ts[e0] * 256 + (si.x & 0xfffffu), p1 = (size_t)ts[e1] * 256 + (si.y & 0xfffffu);
            const float w0 = __uint_as_float(si.z), w1 = __uint_as_float(si.w);
            const float* g2 = mod + ((size_t)comb_layer * 33 + mrow) * (NMOD * D) + 5 * D;
#pragma unroll
            for (int j = 0; j < 4; ++j) {
                const u32x2 a = *(const u32x2*)(Y + p0 * D + 4 * F.lane + 256 * j), b = *(const u32x2*)(Y + p1 * D + 4 * F.lane + 256 * j);
                const f32x4 gg = *(const f32x4*)(g2 + 4 * F.lane + 256 * j);
                f32x4 ya = {bf2f(a.x & 0xffffu), bf2f(a.x >> 16), bf2f(a.y & 0xffffu), bf2f(a.y >> 16)};
                f32x4 yb = {bf2f(b.x & 0xffffu), bf2f(b.x >> 16), bf2f(b.y & 0xffffu), bf2f(b.y >> 16)};
                v[j] = v[j] + gg * (ya * w0 + yb * w1);
                if (MODE == 0 && !dry) *(f32x4*)(xout + 4 * F.lane + 256 * j) = v[j];
            }
        }
        float ss = 0.f;
#pragma unroll
        for (int j = 0; j < 4; ++j) ss += (v[j].x * v[j].x + v[j].y * v[j].y) + (v[j].z * v[j].z + v[j].w * v[j].w);
        const float rstd = 1.0f / sqrtf(wave_sum(ss) * (1.0f / D) + EPS);
        if (MODE == 0) {
            const float* mp = mod + ((size_t)layer * 33 + mrow) * (NMOD * D);
#pragma unroll
            for (int j = 0; j < 4; ++j) { const f32x4 sh = *(const f32x4*)(mp + 4 * F.lane + 256 * j), sc = *(const f32x4*)(mp + D + 4 * F.lane + 256 * j);
                const f32x4 h = (v[j] * rstd * g[j]) * (sc + 1.0f) + sh;
                u32x2 o; o.x = pk2(h.x, h.y); o.y = pk2(h.z, h.w);
                *(u32x2*)(H + (size_t)r * D + 4 * F.lane + 256 * j) = o; }
        } else {
#pragma unroll
            for (int j = 0; j < 4; ++j) *(f32x4*)(xout + 4 * F.lane + 256 * j) = v[j] * rstd * g[j];
        }
    }
}

struct AttnUnit { int qrow0, qpos0, qcol, kcol, vcol, ocol, krow_ctx, krow_band, nband, kpos0, masked, has_sink; float sink2; };
__device__ __forceinline__ int crow(int r, int hi) { return (r & 3) + 8 * (r >> 2) + 4 * hi; }
__device__ __forceinline__ s16x4 vtr(const LAS unsigned char* p) { typedef short v4i16_t __attribute__((ext_vector_type(4))); return __builtin_bit_cast(s16x4, __builtin_amdgcn_ds_read_tr16_b64_v4i16((LAS v4i16_t*)p)); }
constexpr int AT_PITCH = 144, AT_K = 0, AT_V = 64 * AT_PITCH, AT_WS = 2 * 64 * AT_PITCH;
__device__ __forceinline__ void attn_unit_v1(const AttnUnit& u, const bf16_t* proj, bf16_t* mix, LAS unsigned char* lds) {
    int tid = threadIdx.x; asm volatile("" : "+v"(tid));
    const int lane = tid & 63, r32 = lane & 31, hi = lane >> 5; const int wid = __builtin_amdgcn_readfirstlane(tid >> 6);
    LAS unsigned char* Ks = lds + AT_K; LAS unsigned char* Vs = lds + AT_V; LAS float* wsf = (LAS float*)(lds + AT_WS) + wid * 64;
    const bf16_t* qp = proj + (size_t)(u.qrow0 + wid * 32 + r32) * PP + u.qcol + 8 * hi;
    bf16x8 qf[4];
#pragma unroll
    for (int d0 = 0; d0 < 4; ++d0) qf[d0] = *(const bf16x8*)(qp + 16 * d0);
    float m = -INFINITY, l = 0.f; f32x16 o0 = {}, o1 = {};
    const int srow = tid >> 3, sch = tid & 7;
    const int ntile = 4 + u.nband;
    const int vq = (lane & 15) >> 2, vp = lane & 3, vg = (lane >> 4) & 1;
    const LAS unsigned char* vbase = Vs + (4 * hi + vq) * AT_PITCH + (16 * vg + 4 * vp) * 2;
    for (int t = 0; t < ntile; ++t) {
        const int krow = (t < 4) ? u.krow_ctx + 64 * t : u.krow_band + 64 * (t - 4);
        const bf16_t* src = proj + (size_t)(krow + srow) * PP + sch * 8;
        const u32x4 kv = *(const u32x4*)(src + u.kcol); const u32x4 vv = *(const u32x4*)(src + u.vcol);
        __syncthreads();
        *(LAS u32x4*)(Ks + srow * AT_PITCH + sch * 16) = kv; *(LAS u32x4*)(Vs + srow * AT_PITCH + sch * 16) = vv;
        __syncthreads();
        f32x16 p0 = {}, p1 = {};
#pragma unroll
        for (int d0 = 0; d0 < 4; ++d0) {
            const bf16x8 a0 = *(const LAS bf16x8*)(Ks + r32 * AT_PITCH + (16 * d0 + 8 * hi) * 2);
            const bf16x8 a1 = *(const LAS bf16x8*)(Ks + (32 + r32) * AT_PITCH + (16 * d0 + 8 * hi) * 2);
            p0 = __builtin_amdgcn_mfma_f32_32x32x16_bf16(a0, qf[d0], p0, 0, 0, 0);
            p1 = __builtin_amdgcn_mfma_f32_32x32x16_bf16(a1, qf[d0], p1, 0, 0, 0);
        }
        if (u.masked && t >= 4) {
            const int qpos = u.qpos0 + wid * 32 + r32, kb = u.kpos0 + 64 * (t - 4) + 4 * hi;
#pragma unroll
            for (int r = 0; r < 16; ++r) { const int dd = kb + (r & 3) + 8 * (r >> 2) - qpos;
                if (dd > 128 || dd < -128) p0[r] = -INFINITY;
                if (dd + 32 > 128 || dd + 32 < -128) p1[r] = -INFINITY; }
        }
        float mx = fmaxf(p0[0], p1[0]);
#pragma unroll
        for (int r = 1; r < 16; ++r) mx = fmaxf(mx, fmaxf(p0[r], p1[r]));
        mx = fmaxf(mx, __shfl_xor(mx, 32));
        const float mn = fmaxf(m, mx);
        const float alpha = __builtin_amdgcn_exp2f(m - mn);
        float ls = 0.f;
#pragma unroll
        for (int r = 0; r < 16; ++r) { p0[r] = __builtin_amdgcn_exp2f(p0[r] - mn); p1[r] = __builtin_amdgcn_exp2f(p1[r] - mn); ls += p0[r] + p1[r]; }
        l = l * alpha + ls; m = mn;
        if (hi == 0) wsf[r32] = alpha;
        LDS_WAIT();
#pragma unroll
        for (int r = 0; r < 16; ++r) { const float a = wsf[crow(r, hi)]; o0[r] *= a; o1[r] *= a; }
        bf16x8 pa[4];
#pragma unroll
        for (int ks = 0; ks < 4; ++ks) {
            u32x4 w;
            if (ks < 2) { const int b = 8 * ks; w.x = pk2(p0[b], p0[b + 1]); w.y = pk2(p0[b + 2], p0[b + 3]); w.z = pk2(p0[b + 4], p0[b + 5]); w.w = pk2(p0[b + 6], p0[b + 7]); }
            else { const int b = 8 * (ks - 2); w.x = pk2(p1[b], p1[b + 1]); w.y = pk2(p1[b + 2], p1[b + 3]); w.z = pk2(p1[b + 4], p1[b + 5]); w.w = pk2(p1[b + 6], p1[b + 7]); }
            pa[ks] = __builtin_bit_cast(bf16x8, w);
        }
#pragma unroll
        for (int ks = 0; ks < 4; ++ks) {
            const int kb = 32 * (ks >> 1) + 16 * (ks & 1);
#pragma unroll
            for (int d0 = 0; d0 < 2; ++d0) {
                const s16x4 lo = vtr(vbase + kb * AT_PITCH + d0 * 64), hh = vtr(vbase + (kb + 8) * AT_PITCH + d0 * 64);
                const bf16x8 vf = {lo[0], lo[1], lo[2], lo[3], hh[0], hh[1], hh[2], hh[3]};
                if (d0 == 0) o0 = __builtin_amdgcn_mfma_f32_32x32x16_bf16(pa[ks], vf, o0, 0, 0, 0);
                else o1 = __builtin_amdgcn_mfma_f32_32x32x16_bf16(pa[ks], vf, o1, 0, 0, 0);
            }
        }
    }
    l += __shfl_xor(l, 32);
    if (u.has_sink) l += __builtin_amdgcn_exp2f(u.sink2 - m);
    LDS_WAIT();
    if (hi == 0) wsf[32 + r32] = l;
    LDS_WAIT();
#pragma unroll
    for (int r = 0; r < 16; ++r) { const int q = crow(r, hi); const float rl = 1.0f / wsf[32 + q];
        bf16_t* op = mix + (size_t)(u.qrow0 + wid * 32 + q) * DMIX + u.ocol + r32;
        op[0] = (bf16_t)f2bf(o0[r] * rl); op[32] = (bf16_t)f2bf(o1[r] * rl); }
    LDS_WAIT();
}
namespace att {
constexpr int NW = 8, QBLK = 32, KVBLK = 64, NSLOT = 3, SLOTB = 8192;
constexpr int LDS_K = 0, LDS_V = NSLOT * SLOTB, LDS_WS = 2 * NSLOT * SLOTB, LDS_OST = LDS_WS + NW * 64 * 4, LDS_BYTES_ATT = LDS_OST + NW * 4096;
#define SBAR() __builtin_amdgcn_sched_barrier(0)
__device__ __forceinline__ void glds16(const void* gsrc, unsigned lds_dst) { unsigned keep;
    asm volatile("s_mov_b32 %0, m0\n\ts_mov_b32 m0, %2\n\ts_nop 0\n\tglobal_load_lds_dwordx4 %1, off\n\ts_mov_b32 m0, %0" : "=&s"(keep) : "v"(gsrc), "s"(lds_dst) : "memory"); }
__device__ __forceinline__ float max3f(float a, float b, float c) { float r; asm("v_max3_f32 %0, %1, %2, %3" : "=v"(r) : "v"(a), "v"(b), "v"(c)); return r; }
__device__ __forceinline__ float max2f(float a, float b) { float r; asm("v_max_f32_e32 %0, %1, %2" : "=v"(r) : "v"(a), "v"(b)); return r; }
__device__ __forceinline__ float fadd_s(float a, float b) { float r; asm("v_add_f32_e32 %0, %1, %2" : "=v"(r) : "v"(a), "v"(b)); return r; }
__device__ __forceinline__ float fsub_s(float a, float b) { float r; asm("v_sub_f32_e32 %0, %1, %2" : "=v"(r) : "v"(a), "v"(b)); return r; }
typedef __bf16 bf16x2_t __attribute__((ext_vector_type(2)));
__device__ __forceinline__ unsigned cvtpk_s(float lo, float hi) { f32x2 v = {lo, hi}; bf16x2_t b = __builtin_convertvector(v, bf16x2_t); return __builtin_bit_cast(unsigned, b); }
#define WAIT_BAR(N) asm volatile("s_waitcnt vmcnt(" #N ") lgkmcnt(0)\n\ts_barrier" ::: "memory")
typedef const LAS char* lds_cptr;
typedef short v4i16_t __attribute__((ext_vector_type(4)));
__device__ __forceinline__ void kload8(bf16x8* kf, lds_cptr kp) {
    kf[0] = *(const LAS bf16x8*)(kp);        kf[1] = *(const LAS bf16x8*)(kp + 512);
    kf[2] = *(const LAS bf16x8*)(kp + 2048); kf[3] = *(const LAS bf16x8*)(kp + 2560);
    kf[4] = *(const LAS bf16x8*)(kp + 4096); kf[5] = *(const LAS bf16x8*)(kp + 4608);
    kf[6] = *(const LAS bf16x8*)(kp + 6144); kf[7] = *(const LAS bf16x8*)(kp + 6656);
}
__device__ __forceinline__ void kload2(bf16x8* kf, lds_cptr kp, int j) { kf[2 * j] = *(const LAS bf16x8*)(kp + j * 2048); kf[2 * j + 1] = *(const LAS bf16x8*)(kp + j * 2048 + 512); }
__device__ __forceinline__ s16x4 vtr2(lds_cptr p) { return __builtin_bit_cast(s16x4, __builtin_amdgcn_ds_read_tr16_b64_v4i16((LAS v4i16_t*)p)); }
__device__ __forceinline__ float rowmax(const f32x16& p0, const f32x16& p1) {
    float a = max3f(p0[0], p0[1], p1[0]), b = max3f(p0[2], p0[3], p1[1]); a = max3f(a, p1[2], p1[3]);
#pragma unroll
    for (int r = 4; r < 16; r += 4) { a = max3f(a, p0[r], p0[r + 1]); b = max3f(b, p0[r + 2], p0[r + 3]); a = max3f(a, p1[r], p1[r + 1]); b = max3f(b, p1[r + 2], p1[r + 3]); }
    const float m = max2f(a, b);
    auto rr = __builtin_amdgcn_permlane32_swap(__float_as_uint(m), __float_as_uint(m), false, false);
    return max2f(__uint_as_float(rr[0]), __uint_as_float(rr[1]));
}
__device__ __forceinline__ void wmask(f32x16& p0, f32x16& p1, int kb, int qpos) {
    const float NEG = -INFINITY;
#pragma unroll
    for (int r = 0; r < 16; ++r) { const int dd = kb + (r & 3) + 8 * (r >> 2) - qpos;
        if (dd > 128 || dd < -128) p0[r] = NEG;
        if (dd + 32 > 128 || dd + 32 < -128) p1[r] = NEG; }
}
__device__ __forceinline__ void qkt(f32x16& p0, f32x16& p1, lds_cptr Kslot, const bf16x8* qr, const f32x16& negm, int r32, int hi) {
    lds_cptr kb = Kslot + hi * 1024 + r32 * 16;
#pragma unroll
    for (int d0 = 0; d0 < 4; ++d0) {
        const bf16x8 b0 = *(const LAS bf16x8*)(kb + d0 * 2048);
        const bf16x8 b1 = *(const LAS bf16x8*)(kb + d0 * 2048 + 512);
        if (d0 == 0) { p0 = __builtin_amdgcn_mfma_f32_32x32x16_bf16(b0, qr[0], negm, 0, 0, 0); p1 = __builtin_amdgcn_mfma_f32_32x32x16_bf16(b1, qr[0], negm, 0, 0, 0); }
        else { p0 = __builtin_amdgcn_mfma_f32_32x32x16_bf16(b0, qr[d0], p0, 0, 0, 0); p1 = __builtin_amdgcn_mfma_f32_32x32x16_bf16(b1, qr[d0], p1, 0, 0, 0); } }
}
__device__ __forceinline__ void pv(f32x16* o, int vb, bf16x8 pa0, bf16x8 pa1, bf16x8 pa2, bf16x8 pa3) {
#pragma unroll
    for (int d0 = 0; d0 < 2; ++d0) { s16x4 lo[4], hi[4];
#pragma unroll
        for (int ks = 0; ks < 4; ++ks) {
            asm volatile("ds_read_b64_tr_b16 %0,%1 offset:%c2" : "=&v"(lo[ks]) : "v"(vb), "i"(d0 * 4096 + ks * 1024) : "memory");
            asm volatile("ds_read_b64_tr_b16 %0,%1 offset:%c2" : "=&v"(hi[ks]) : "v"(vb), "i"(d0 * 4096 + ks * 1024 + 512) : "memory"); }
        asm volatile("s_waitcnt lgkmcnt(0)" ::: "memory"); SBAR();
#define PK(k) (bf16x8){lo[k][0], lo[k][1], lo[k][2], lo[k][3], hi[k][0], hi[k][1], hi[k][2], hi[k][3]}
        o[d0] = __builtin_amdgcn_mfma_f32_32x32x16_bf16(pa0, PK(0), o[d0], 0, 0, 0);
        o[d0] = __builtin_amdgcn_mfma_f32_32x32x16_bf16(pa1, PK(1), o[d0], 0, 0, 0);
        o[d0] = __builtin_amdgcn_mfma_f32_32x32x16_bf16(pa2, PK(2), o[d0], 0, 0, 0);
        o[d0] = __builtin_amdgcn_mfma_f32_32x32x16_bf16(pa3, PK(3), o[d0], 0, 0, 0);
#undef PK
    }
}
template <bool MASKED, int THRL>
__device__ __forceinline__ void attn_unit2(const AttnUnit& u, const bf16_t* proj, bf16_t* mix, LAS unsigned char* shm) {
    int tid = threadIdx.x; asm volatile("" : "+v"(tid));
    const int lane = tid & 63, r32 = lane & 31, hi = lane >> 5; const int wid = __builtin_amdgcn_readfirstlane(tid >> 6);
    const bf16_t* Qw = proj + (size_t)(u.qrow0 + wid * QBLK) * PP + u.qcol;
    const unsigned lds0 = (unsigned)(uintptr_t)shm;
    LAS float* wsf = (LAS float*)(shm + LDS_WS) + wid * 64;
    const bf16_t* ksrc = proj + (size_t)lane * PP + u.kcol + wid * 8;
    const bf16_t* vsrc = proj + (size_t)(16 * (wid & 3) + (lane >> 2)) * PP + u.vcol + (wid >> 2) * 32 + (lane & 3) * 8;
    const unsigned kdst = lds0 + LDS_K + wid * 1024, vdst = lds0 + LDS_V + wid * 1024;
    const int krow_ctx = u.krow_ctx, krow_band = u.krow_band - 4 * KVBLK;
#define TROW(t) ((t) < 4 ? krow_ctx + (t) * KVBLK : krow_band + (t) * KVBLK)
#define DMA_K(t, slot) glds16(ksrc + (size_t)TROW(t) * PP, (unsigned)__builtin_amdgcn_readfirstlane(kdst + (slot)))
#define DMA_V(t, slot) glds16(vsrc + (size_t)TROW(t) * PP, (unsigned)__builtin_amdgcn_readfirstlane(vdst + (slot)))
    const int vb0 = (int)(lds0 + LDS_V) + ((lane >> 4) & 1) * 32 + (lane & 3) * 8 + (4 * hi + ((lane & 15) >> 2)) * 64;
    const lds_cptr shm3 = (lds_cptr)shm; const lds_cptr Kbase = shm3 + LDS_K; bf16x8 kf[8];
    const lds_cptr kp0 = shm3 + LDS_K + hi * 1024 + r32 * 16; const lds_cptr vp0 = shm3 + LDS_V + ((lane >> 4) & 1) * 32 + (lane & 3) * 8 + (4 * hi + ((lane & 15) >> 2)) * 64;
    const int NT = 4 + u.nband;
    DMA_K(0, 0); DMA_V(0, 0); DMA_K(1, SLOTB);
    bf16x8 qr[4];
#pragma unroll
    for (int d0 = 0; d0 < 4; ++d0) qr[d0] = *(const bf16x8*)(Qw + (size_t)r32 * PP + d0 * 16 + hi * 8);
    float mhat = 0.f, l_reg = 0.f; f32x16 o[2]; o[0] = f32x16{}; o[1] = f32x16{}; f32x16 negm = f32x16{}; asm volatile("" : "+v"(negm));
    const int qpos = u.qpos0 + wid * QBLK + r32, kposb = u.kpos0 - 4 * KVBLK + 4 * hi;
#define CMASK(P0, P1, t) do { if (MASKED) { if ((t) >= 4) wmask(P0, P1, kposb + (t) * KVBLK, qpos); } } while (0)
    bool resc = false;
#define START(P0, P1) do { const float rm = rowmax(P0, P1); resc = false; \
    { const float dl = rm; mhat = fadd_s(mhat, dl); \
      _Pragma("unroll") for (int r = 0; r < 16; ++r) { P0[r] = fsub_s(P0[r], dl); P1[r] = fsub_s(P1[r], dl); } \
      _Pragma("unroll") for (int r = 0; r < 16; ++r) negm[r] = -mhat; asm volatile("" : "+v"(negm)); } \
    _Pragma("unroll") for (int r = 0; r < 16; ++r) P0[r] = __builtin_amdgcn_exp2f(P0[r]); } while (0)
#define RESC() do { if (resc) { asm volatile("s_waitcnt lgkmcnt(0)" ::: "memory"); \
      _Pragma("unroll") for (int d_ = 0; d_ < 2; ++d_) _Pragma("unroll") for (int r = 0; r < 16; ++r) o[d_][r] *= wsf[crow(r, hi)]; } } while (0)
    f32x16 pA0, pA1, pB0, pB1;
    int sl_prev = 0, sl_cur = 0, sl_next = SLOTB;
#define ROT() do { sl_prev = sl_cur; sl_cur = sl_next; sl_next = (sl_next == (NSLOT - 1) * SLOTB) ? 0 : sl_next + SLOTB; } while (0)
    DMA_K(2, 2 * SLOTB);
    WAIT_BAR(3);
    qkt(pA0, pA1, Kbase, qr, negm, r32, hi); asm volatile("s_nop 15\n\ts_nop 7" : "+v"(pA0), "+v"(pA1));
    START(pA0, pA1);
    _Pragma("unroll") for (int r = 0; r < 16; ++r) pA1[r] = __builtin_amdgcn_exp2f(pA1[r]);
    WAIT_BAR(0);
    DMA_K(3, 0); DMA_V(1, SLOTB);
    ROT();
    kload8(kf, kp0 + sl_cur);
    WAIT_BAR(2);
    s16x4 vlo[8], vhi[8]; u32x4 pw0, pw1, pw2, pw3;
#define PKW(P, B) cvtpk_s(P[B], P[B + 1])
#define PAF(k) __builtin_bit_cast(bf16x8, pw##k)
#define VFR(i) (bf16x8){vlo[i][0], vlo[i][1], vlo[i][2], vlo[i][3], vhi[i][0], vhi[i][1], vhi[i][2], vhi[i][3]}
#define PIN(x) asm volatile("" : "+v"(x))
#define MX3(a, b, c) __builtin_fmaxf(__builtin_fmaxf((a), (b)), (c))
#define GAPA(MF, A0, A1, A2, A3, W0, W1, PW) do { MF; sacc += A0; sacc += A1; sacc += A2; sacc += A3; PIN(sacc); W0; W1; PIN(PW); SBAR(); } while (0)
#define EX(v) __builtin_amdgcn_exp2f(v)
#define GAPB(MF, X, B) do { MF; X[B] = EX(X[B]); X[B + 1] = EX(X[B + 1]); X[B + 2] = EX(X[B + 2]); X[B + 3] = EX(X[B + 3]); PIN(X); SBAR(); } while (0)
#define VRD(i) do { vlo[i] = vtr2(vp_ + (((i) >> 2) * 4096 + ((i) & 3) * 1024)); vhi[i] = vtr2(vp_ + (((i) >> 2) * 4096 + ((i) & 3) * 1024 + 512)); } while (0)
#define KRD(G, j) do { if (G) { kload2(kf, kp0 + sl_next, j); SBAR(); } } while (0)
#define STEP(C0, C1, P0, P1, t, GK, GV, GL) do { SBAR(); \
    const lds_cptr vp_ = vp0 + sl_prev; \
    VRD(0); SBAR(); float sacc = (P0[0] + P0[1]); \
    GAPA(C0 = __builtin_amdgcn_mfma_f32_32x32x16_bf16(kf[0], qr[0], negm, 0, 0, 0), P0[2], P0[3], P0[4], P0[5],     pw0[0] = PKW(P0, 0), pw0[1] = PKW(P0, 2), pw0); \
    VRD(4); SBAR(); GAPA(C1 = __builtin_amdgcn_mfma_f32_32x32x16_bf16(kf[1], qr[0], negm, 0, 0, 0), P0[6], P0[7], P0[8], P0[9],     pw0[2] = PKW(P0, 4), pw0[3] = PKW(P0, 6), pw0); \
    VRD(1); SBAR(); GAPA(C0 = __builtin_amdgcn_mfma_f32_32x32x16_bf16(kf[2], qr[1], C0, 0, 0, 0),   P0[10], P0[11], P0[12], P0[13], pw1[0] = PKW(P0, 8), pw1[1] = PKW(P0, 10), pw1); \
    VRD(5); SBAR(); GAPA(C1 = __builtin_amdgcn_mfma_f32_32x32x16_bf16(kf[3], qr[1], C1, 0, 0, 0),   P0[14], P0[15], P1[0], P1[1],   pw1[2] = PKW(P0, 12), pw1[3] = PKW(P0, 14), pw1); \
    VRD(2); SBAR(); GAPA(C0 = __builtin_amdgcn_mfma_f32_32x32x16_bf16(kf[4], qr[2], C0, 0, 0, 0),   P1[2], P1[3], P1[4], P1[5],     pw2[0] = PKW(P1, 0), pw2[1] = PKW(P1, 2), pw2); \
    VRD(6); SBAR(); GAPA(C1 = __builtin_amdgcn_mfma_f32_32x32x16_bf16(kf[5], qr[2], C1, 0, 0, 0),   P1[6], P1[7], P1[8], P1[9],     pw2[2] = PKW(P1, 4), pw2[3] = PKW(P1, 6), pw2); \
    VRD(3); SBAR(); GAPA(C0 = __builtin_amdgcn_mfma_f32_32x32x16_bf16(kf[6], qr[3], C0, 0, 0, 0),   P1[10], P1[11], P1[12], P1[13], pw3[0] = PKW(P1, 8), pw3[1] = PKW(P1, 10), pw3); \
    VRD(7); SBAR(); GAPA(C1 = __builtin_amdgcn_mfma_f32_32x32x16_bf16(kf[7], qr[3], C1, 0, 0, 0),   P1[14], P1[15], 0.f, 0.f,       pw3[2] = PKW(P1, 12), pw3[3] = PKW(P1, 14), pw3); \
    l_reg += sacc; \
    if (GK) { DMA_K((t) + 3, sl_cur); } if (GV) { DMA_V((t) + 1, sl_next); } \
    CMASK(C0, C1, t); \
    { float a = MX3(C0[0], C0[1], C1[0]), b = MX3(C0[2], C0[3], C1[1]); a = MX3(a, C1[2], C1[3]); \
      _Pragma("unroll") for (int r = 4; r < 16; r += 4) { a = MX3(a, C0[r], C0[r + 1]); b = MX3(b, C0[r + 2], C0[r + 3]); a = MX3(a, C1[r], C1[r + 1]); b = MX3(b, C1[r + 2], C1[r + 3]); } \
      float rm = __builtin_fmaxf(a, b); { auto rr = __builtin_amdgcn_permlane32_swap(__float_as_uint(rm), __float_as_uint(rm), false, false); rm = __builtin_fmaxf(__uint_as_float(rr[0]), __uint_as_float(rr[1])); } \
      resc = false; \
      if (__builtin_expect(__any(rm > (float)THRL), 0)) { const float dl = __builtin_fmaxf(rm, 0.f); mhat += dl; \
        _Pragma("unroll") for (int r = 0; r < 16; ++r) { C0[r] -= dl; C1[r] -= dl; } \
        _Pragma("unroll") for (int r = 0; r < 16; ++r) negm[r] = -mhat; asm volatile("" : "+v"(negm)); \
        const float f = __builtin_amdgcn_exp2f(-dl); l_reg *= f; if (hi == 0) wsf[r32] = f; resc = true; } } \
    SBAR(); \
    GAPB(o[0] = __builtin_amdgcn_mfma_f32_32x32x16_bf16(PAF(0), VFR(0), o[0], 0, 0, 0), C0, 0); \
    GAPB(o[1] = __builtin_amdgcn_mfma_f32_32x32x16_bf16(PAF(0), VFR(4), o[1], 0, 0, 0), C0, 4); \
    KRD(GL, 0); GAPB(o[0] = __builtin_amdgcn_mfma_f32_32x32x16_bf16(PAF(1), VFR(1), o[0], 0, 0, 0), C0, 8); \
    KRD(GL, 1); GAPB(o[1] = __builtin_amdgcn_mfma_f32_32x32x16_bf16(PAF(1), VFR(5), o[1], 0, 0, 0), C0, 12); \
    KRD(GL, 2); GAPB(o[0] = __builtin_amdgcn_mfma_f32_32x32x16_bf16(PAF(2), VFR(2), o[0], 0, 0, 0), C1, 0); \
    KRD(GL, 3); GAPB(o[1] = __builtin_amdgcn_mfma_f32_32x32x16_bf16(PAF(2), VFR(6), o[1], 0, 0, 0), C1, 4); \
    GAPB(o[0] = __builtin_amdgcn_mfma_f32_32x32x16_bf16(PAF(3), VFR(3), o[0], 0, 0, 0), C1, 8); \
    GAPB(o[1] = __builtin_amdgcn_mfma_f32_32x32x16_bf16(PAF(3), VFR(7), o[1], 0, 0, 0), C1, 12); \
    } while (0)
    int t = 1;
    for (; t + 5 < NT; t += 2) {
        STEP(pB0, pB1, pA0, pA1, t, true, true, true);     WAIT_BAR(2); RESC(); ROT();
        STEP(pA0, pA1, pB0, pB1, t + 1, true, true, true); WAIT_BAR(2); RESC(); ROT();
    }
#define ENDW(tt) do { if ((tt) + 3 < NT) { WAIT_BAR(2); } else if ((tt) + 2 < NT) { WAIT_BAR(1); } else { WAIT_BAR(0); } } while (0)
    for (; t + 1 < NT; t += 2) {
        STEP(pB0, pB1, pA0, pA1, t, (t + 3 < NT), (t + 1 < NT), (t + 1 < NT));       ENDW(t);     RESC(); ROT();
        STEP(pA0, pA1, pB0, pB1, t + 1, (t + 4 < NT), (t + 2 < NT), (t + 2 < NT));   ENDW(t + 1); RESC(); ROT();
    }
    STEP(pB0, pB1, pA0, pA1, NT - 1, false, false, false); RESC();
    { float sacc = pB0[0] + pB0[1]; _Pragma("unroll") for (int r = 2; r < 16; ++r) sacc += pB0[r]; _Pragma("unroll") for (int r = 0; r < 16; ++r) sacc += pB1[r]; l_reg += sacc;
      pw0 = (u32x4){PKW(pB0, 0), PKW(pB0, 2), PKW(pB0, 4), PKW(pB0, 6)}; pw1 = (u32x4){PKW(pB0, 8), PKW(pB0, 10), PKW(pB0, 12), PKW(pB0, 14)}; pw2 = (u32x4){PKW(pB1, 0), PKW(pB1, 2), PKW(pB1, 4), PKW(pB1, 6)}; pw3 = (u32x4){PKW(pB1, 8), PKW(pB1, 10), PKW(pB1, 12), PKW(pB1, 14)};
      SBAR(); pv(o, vb0 + sl_cur, PAF(0), PAF(1), PAF(2), PAF(3)); }
#undef PKW
#undef PAF
#undef VFR
#undef PIN
#undef MX3
#undef GAPA
#undef GAPB
#undef EX
#undef VRD
#undef KRD
#undef STEP
#undef ENDW
    { auto rr = __builtin_amdgcn_permlane32_swap(__float_as_uint(l_reg), __float_as_uint(l_reg), false, false); l_reg = __uint_as_float(rr[0]) + __uint_as_float(rr[1]); }
    if (u.has_sink) l_reg += __builtin_amdgcn_exp2f(u.sink2 - mhat);
    if (hi == 0) wsf[32 + r32] = l_reg; asm volatile("s_waitcnt lgkmcnt(0)" ::: "memory");
    float rli[16];
#pragma unroll
    for (int r = 0; r < 16; ++r) rli[r] = __builtin_amdgcn_rcpf(wsf[32 + crow(r, hi)]);
    bf16_t* Ow = mix + (size_t)(u.qrow0 + wid * QBLK) * DMIX + u.ocol;
    { LAS bf16_t* stg = (LAS bf16_t*)(shm + LDS_OST) + wid * 2048;
#pragma unroll
      for (int r = 0; r < 16; ++r) { const int orow = crow(r, hi);
#pragma unroll
          for (int d0 = 0; d0 < 2; ++d0) stg[orow * 64 + d0 * 32 + r32] = (bf16_t)f2bf(o[d0][r] * rli[r]); }
      asm volatile("s_waitcnt lgkmcnt(0)" ::: "memory");
#pragma unroll
      for (int i = 0; i < 4; ++i) { const int row = i * 8 + (lane >> 3), ch = lane & 7; const u32x4 v = *(const LAS u32x4*)(stg + row * 64 + ch * 8); *(u32x4*)(Ow + (size_t)row * DMIX + ch * 8) = v; } }
    asm volatile("s_waitcnt lgkmcnt(0)\n\ts_barrier" ::: "memory");
#undef DMA_K
#undef DMA_V
#undef TROW
#undef CMASK
#undef START
#undef RESC
#undef ROT
}
#undef SBAR
#undef WAIT_BAR
}

constexpr int CV_H = 0, CV_W = 49152;
__device__ __forceinline__ void conv_unit(Frame& F, int layer, int R0, int L, int t0, const bf16_t* proj, bf16_t* mix) {
    LAS unsigned char* hs = F.lds + CV_H; const LAS float* cw = (const LAS float*)(F.lds + CV_W);
    __syncthreads();
    for (int idx = F.tid; idx < 94 * 32; idx += 512) { const int row = idx >> 5, ch = idx & 31, tp = t0 - 15 + row;
        u32x4 v = {0u, 0u, 0u, 0u};
        if (tp >= 0 && tp < L) v = *(const u32x4*)(proj + (size_t)(R0 + tp) * PP + C_BU + ch * 8);
        *(LAS u32x4*)(hs + row * 512 + ch * 16) = v; }
    __syncthreads();
    const int c4 = F.lane * 4;
    const f32x4 bias = *(const f32x4*)(F.in[I_CONVB] + layer * BCH + c4), lg = *(const f32x4*)(F.in[I_LNG] + layer * BCH + c4), lb = *(const f32x4*)(F.in[I_LNB] + layer * BCH + c4);
    for (int i = 0; i < 8; ++i) {
        const int tt = F.wave * 8 + i;
        f32x4 acc = bias;
#pragma unroll
        for (int k = 0; k < CONVW; ++k) { const u32x2 xr = *(const LAS u32x2*)(hs + (tt + k) * 512 + F.lane * 8); const f32x4 wv = *(const LAS f32x4*)(cw + k * 256 + c4);
            acc.x += bf2f(xr.x & 0xffffu) * wv.x; acc.y += bf2f(xr.x >> 16) * wv.y; acc.z += bf2f(xr.y & 0xffffu) * wv.z; acc.w += bf2f(xr.y >> 16) * wv.w; }
        const float mean = wave_sum((acc.x + acc.y) + (acc.z + acc.w)) * (1.0f / BCH);
        const f32x4 d = acc - mean;
        const float var = wave_sum((d.x * d.x + d.y * d.y) + (d.z * d.z + d.w * d.w)) * (1.0f / BCH);
        const f32x4 y = d * (1.0f / sqrtf(var + EPS)) * lg + lb;
        f32x4 s; s.x = y.x / (1.0f + __expf(-y.x)); s.y = y.y / (1.0f + __expf(-y.y)); s.z = y.z / (1.0f + __expf(-y.z)); s.w = y.w / (1.0f + __expf(-y.w));
        u32x2 o; o.x = pk2(s.x, s.y); o.y = pk2(s.z, s.w);
        *(u32x2*)(mix + (size_t)(R0 + t0 + tt) * DMIX + O_B + c4) = o;
    }
}
__device__ __forceinline__ void p4_mixers(Frame& F, int layer) {
    frame_ids(F);
    const bf16_t* proj = (const bf16_t*)(F.ws + WS_PROJ); bf16_t* mix = (bf16_t*)(F.ws + WS_H);
    const bool with_ctx = layer < DEPTH - 1;
    const int n_att = 3072 + (with_ctx ? 384 : 0);
    for (int un = F.vcu; un < n_att; un += F.G) {
        AttnUnit u; int kind, idx;
        if (un < 1536) { kind = 0; idx = un; } else if (un < 3072) { kind = 1; idx = un - 1536; } else if (un < 3264) { kind = 2; idx = un - 3072; } else { kind = 3; idx = un - 3264; }
        const bool isC = kind & 1, isctx = kind >= 2;
        int b, h, qb;
        if (!isctx) { qb = idx & 7; h = (idx >> 3) % 6; b = idx / 48; } else { qb = 0; h = idx % 6; b = idx / 6; }
        const int kvh = h / 3;
        u.qcol = (isC ? C_CQ : C_AQ) + h * 64; u.kcol = (isC ? C_CK : C_AK) + kvh * 64; u.vcol = (isC ? C_CV : C_AV) + kvh * 64; u.ocol = (isC ? O_C : O_A) + h * 64;
        u.krow_ctx = NLAT + b * CTXL;
        u.has_sink = isC; u.sink2 = isC ? F.in[I_SINK][layer * 6 + h] * LOG2E : 0.f;
        if (isctx) { u.qrow0 = NLAT + b * CTXL; u.qpos0 = 0; u.nband = 0; u.krow_band = 0; u.kpos0 = 0; u.masked = 0; }
        else {
            u.qrow0 = b * SEQ + qb * 256; u.qpos0 = qb * 256;
            if (isC) { const int ks = qb * 256 - 128 < 0 ? 0 : qb * 256 - 128, ke = qb * 256 + 384 > SEQ ? SEQ : qb * 256 + 384;
                u.kpos0 = ks; u.nband = (ke - ks) >> 6; u.krow_band = b * SEQ + ks; u.masked = 1; }
            else { u.kpos0 = 0; u.nband = SEQ / 64; u.krow_band = b * SEQ; u.masked = 0; }
        }
        if (isC && !isctx) att::attn_unit2<true, 8>(u, proj, mix, F.lds); else att::attn_unit2<false, 8>(u, proj, mix, F.lds);
        if ((REP_MASK & 4) && !isC) att::attn_unit2<false, 8>(u, proj, mix, F.lds);
        if ((REP_MASK & 8) && isC) { if (!isctx) att::attn_unit2<true, 8>(u, proj, mix, F.lds); else att::attn_unit2<false, 8>(u, proj, mix, F.lds); }
    }
    __syncthreads();
    { LAS float* cw = (LAS float*)(F.lds + CV_W);
      for (int idx = F.tid; idx < CONVW * BCH; idx += 512) cw[idx] = F.in[I_CONVW][layer * CONVW * BCH + idx]; }
    const int n_conv = 1024 + (with_ctx ? 128 : 0);
    for (int un = F.vcu; un < n_conv; un += F.G) {
        if (un < 1024) conv_unit(F, layer, (un >> 5) * SEQ, SEQ, (un & 31) * 64, proj, mix);
        else conv_unit(F, layer, NLAT + ((un - 1024) >> 2) * CTXL, CTXL, ((un - 1024) & 3) * 64, proj, mix);
        if (REP_MASK & 16) { if (un < 1024) conv_unit(F, layer, (un >> 5) * SEQ, SEQ, (un & 31) * 64, proj, mix);
            else conv_unit(F, layer, NLAT + ((un - 1024) >> 2) * CTXL, CTXL, ((un - 1024) & 3) * 64, proj, mix); }
    }
    __syncthreads();
}

constexpr int RT_PITCH = 2064;
constexpr int RT_AH = 0, RT_AL = 16 * RT_PITCH, RT_RED = 2 * 16 * RT_PITCH, RT_FIN = RT_RED + 8 * 16 * 48 * 4;
__device__ __forceinline__ void p6_router(Frame& F, int layer, int nrows, bool commit = true) {
    frame_ids(F);
    LAS unsigned char* AH = F.lds + RT_AH; LAS unsigned char* AL = F.lds + RT_AL;
    LAS float* RED = (LAS float*)(F.lds + RT_RED); LAS float* FIN = (LAS float*)(F.lds + RT_FIN);
    LAS unsigned* rec = (LAS unsigned*)(F.lds + LDS_REC);
    LAS unsigned* hist = (LAS unsigned*)(F.lds + LDS_MISC) + 64; LAS unsigned* base = (LAS unsigned*)(F.lds + LDS_MISC) + 96;
    const float* wg = F.in[I_WGRP] + (size_t)layer * D * 4; const float* we = F.in[I_WEXP] + (size_t)layer * D * NE;
    if (F.tid < NE) hist[F.tid] = 0u;
    const int fr = F.lane & 15, kq = F.lane >> 4;
    bf16x8 bh[3][4], bl[3][4];
#pragma unroll
    for (int nt = 0; nt < 3; ++nt)
#pragma unroll
        for (int ks = 0; ks < 4; ++ks) {
            const int col = 16 * nt + fr;
#pragma unroll
            for (int j = 0; j < 8; ++j) { const int k = 128 * F.wave + 32 * ks + 8 * kq + j;
                const float w = col < 4 ? wg[k * 4 + col] : (col < 36 ? we[k * NE + col - 4] : 0.f);
                const unsigned hi = f2bf(w); const unsigned lo = f2bf(w - bf2f(hi));
                bh[nt][ks][j] = (short)hi; bl[nt][ks][j] = (short)lo; }
        }
    const int rpb = (nrows + F.G - 1) / F.G, rbeg = F.vcu * rpb, rend = rbeg + rpb < nrows ? rbeg + rpb : nrows;
    const float* mod = (const float*)(F.ws + WS_MOD); bf16_t* H = (bf16_t*)(F.ws + WS_H);
    f32x4 g[4];
#pragma unroll
    for (int j = 0; j < 4; ++j) g[j] = *(const f32x4*)(F.in[I_N2G] + layer * D + 4 * F.lane + 256 * j);
    const float* bgp = F.in[I_BGRP] + layer * 4; const float* bep = F.in[I_BEXP] + layer * NE;
    __syncthreads();
    for (int gb = rbeg; gb < rend; gb += 16) {
#pragma unroll
        for (int q = 0; q < 2; ++q) {
            const int lr = 2 * F.wave + q; const bool valid = gb + lr < rend; const int r = valid ? gb + lr : rend - 1;
            const bool lat = r < NLAT; const int mrow = lat ? r / SEQ : BATCH;
            const float* xin = lat ? F.out + (size_t)r * D : (const float*)(F.ws + WS_XC) + (size_t)(r - NLAT) * D;
            f32x4 v[4]; float ss = 0.f;
#pragma unroll
            for (int j = 0; j < 4; ++j) { v[j] = *(const f32x4*)(xin + 4 * F.lane + 256 * j); ss += (v[j].x * v[j].x + v[j].y * v[j].y) + (v[j].z * v[j].z + v[j].w * v[j].w); }
            const float rstd = 1.0f / sqrtf(wave_sum(ss) * (1.0f / D) + EPS);
            const float* mp = mod + ((size_t)layer * 33 + mrow) * (NMOD * D) + 3 * D;
#pragma unroll
            for (int j = 0; j < 4; ++j) { const f32x4 sh = *(const f32x4*)(mp + 4 * F.lane + 256 * j), sc = *(const f32x4*)(mp + D + 4 * F.lane + 256 * j);
                const f32x4 h = (v[j] * rstd * g[j]) * (sc + 1.0f) + sh;
                const unsigned h0 = f2bf(h.x), h1 = f2bf(h.y), h2 = f2bf(h.z), h3 = f2bf(h.w);
                u32x2 o; o.x = h0 | (h1 << 16); o.y = h2 | (h3 << 16);
                u32x2 lo; lo.x = pk2(h.x - bf2f(h0), h.y - bf2f(h1)); lo.y = pk2(h.z - bf2f(h2), h.w - bf2f(h3));
                if (valid) *(u32x2*)(H + (size_t)r * D + 4 * F.lane + 256 * j) = o;
                *(LAS u32x2*)(AH + lr * RT_PITCH + (4 * F.lane + 256 * j) * 2) = o;
                *(LAS u32x2*)(AL + lr * RT_PITCH + (4 * F.lane + 256 * j) * 2) = lo; }
        }
        __syncthreads();
        f32x4 acc[3] = {{0.f, 0.f, 0.f, 0.f}, {0.f, 0.f, 0.f, 0.f}, {0.f, 0.f, 0.f, 0.f}};
#pragma unroll
        for (int ks = 0; ks < 4; ++ks) {
            const bf16x8 ah = *(const LAS bf16x8*)(AH + fr * RT_PITCH + (128 * F.wave + 32 * ks + 8 * kq) * 2);
            const bf16x8 al = *(const LAS bf16x8*)(AL + fr * RT_PITCH + (128 * F.wave + 32 * ks + 8 * kq) * 2);
#pragma unroll
            for (int nt = 0; nt < 3; ++nt) {
                acc[nt] = __builtin_amdgcn_mfma_f32_16x16x32_bf16(ah, bh[nt][ks], acc[nt], 0, 0, 0);
                acc[nt] = __builtin_amdgcn_mfma_f32_16x16x32_bf16(ah, bl[nt][ks], acc[nt], 0, 0, 0);
                acc[nt] = __builtin_amdgcn_mfma_f32_16x16x32_bf16(al, bh[nt][ks], acc[nt], 0, 0, 0);
            }
        }
#pragma unroll
        for (int nt = 0; nt < 3; ++nt)
#pragma unroll
            for (int i = 0; i < 4; ++i) RED[(F.wave * 16 + 4 * kq + i) * 48 + 16 * nt + fr] = acc[nt][i];
        __syncthreads();
        { const int row = F.tid >> 5, e = F.tid & 31; float s = 0.f;
#pragma unroll
          for (int w = 0; w < 8; ++w) s += RED[(w * 16 + row) * 48 + 4 + e];
          FIN[row * 36 + 4 + e] = s;
          if (F.tid < 64) { const int r2 = F.tid >> 2, gi = F.tid & 3; float s2 = 0.f;
#pragma unroll
              for (int w = 0; w < 8; ++w) s2 += RED[(w * 16 + r2) * 48 + gi];
              FIN[r2 * 36 + gi] = s2; } }
        __syncthreads();
        if (F.tid < 16 && gb + F.tid < rend && commit) {
            const LAS float* fl = FIN + F.tid * 36;
            float gl[4];
#pragma unroll
            for (int gi = 0; gi < 4; ++gi) gl[gi] = fl[gi] + bgp[gi];
            int gidx = 0; float gmax = gl[0];
#pragma unroll
            for (int gi = 1; gi < 4; ++gi) if (gl[gi] > gmax) { gmax = gl[gi]; gidx = gi; }
            float gsum = 0.f;
#pragma unroll
            for (int gi = 0; gi < 4; ++gi) gsum += __expf(gl[gi] - gmax);
            const float gval = 1.0f / gsum;
            float el[8];
#pragma unroll
            for (int j = 0; j < 8; ++j) el[j] = fl[4 + gidx * 8 + j] + bep[gidx * 8 + j];
            int i0 = 0; float v0 = el[0];
#pragma unroll
            for (int j = 1; j < 8; ++j) if (el[j] > v0) { v0 = el[j]; i0 = j; }
            int i1 = -1; float v1 = -INFINITY;
#pragma unroll
            for (int j = 0; j < 8; ++j) if (j != i0 && el[j] > v1) { v1 = el[j]; i1 = j; }
            const float t = __expf(v1 - v0), w0 = gval / (1.0f + t), w1 = gval * t / (1.0f + t);
            const int e0 = gidx * 8 + i0, e1 = gidx * 8 + i1;
            const unsigned x0 = atomicAdd((unsigned*)&hist[e0], 1u), x1 = atomicAdd((unsigned*)&hist[e1], 1u);
            LAS unsigned* rp = rec + (size_t)(gb + F.tid - rbeg) * 4;
            rp[0] = (unsigned)e0 | (x0 << 8); rp[1] = (unsigned)e1 | (x1 << 8); rp[2] = __float_as_uint(w0); rp[3] = __float_as_uint(w1);
        }
    }
    __syncthreads();
    if (!commit) return;
    unsigned* cnt = (unsigned*)(F.ws + WS_CTL) + CW_CNT + layer * NE;
    if (F.tid < NE) base[F.tid] = hist[F.tid] ? atomicAdd(&cnt[F.tid], hist[F.tid]) : 0u;
    __syncthreads();
    int* tok = (int*)(F.ws + WS_TOK); u32x4* slot = (u32x4*)(F.ws + WS_SLOT);
    for (int i = F.tid; i < rend - rbeg; i += 512) {
        const LAS unsigned* rp = rec + (size_t)i * 4; const unsigned a = rp[0], b = rp[1];
        const unsigned e0 = a & 0xffu, e1 = b & 0xffu, p0 = base[e0] + (a >> 8), p1 = base[e1] + (b >> 8);
        tok[(size_t)e0 * TOKCAP + p0] = rbeg + i; tok[(size_t)e1 * TOKCAP + p1] = rbeg + i;
        u32x4 s; s.x = (e0 << 20) | p0; s.y = (e1 << 20) | p1; s.z = rp[2]; s.w = rp[3];
        slot[rbeg + i] = s;
    }
    __syncthreads();
}

__global__ void __launch_bounds__(512, 2) hymba_fwd(Args args) {
    extern __shared__ __attribute__((aligned(16))) unsigned char lds_raw[];
    Frame F;
    F.lds = (LAS unsigned char*)lds_raw;
    F.tid = threadIdx.x; F.lane = F.tid & 63; F.wave = __builtin_amdgcn_readfirstlane(F.tid >> 6);
    F.G = gridDim.x; { const int bx = blockIdx.x; F.vcu = (F.G % 8 == 0) ? (bx % 8) * (F.G / 8) + bx / 8 : bx; }
    F.in = args.in; F.out = args.out; F.ws = args.ws;
    for (int u = F.tid; u < 256; u += 512) ((LAS unsigned*)(F.lds + LDS_MISC))[u] = 0u;
    __syncthreads();
    const int lo = args.ph_lo, hi = args.ph_hi;
    XcdBarrier bar; bar.bar = (unsigned*)(F.ws + WS_CTL) + CW_BAR; bar.x = 0; bar.st = nullptr;
    if (hi - lo > 1) bar = xcd_barrier_post((unsigned*)(F.ws + WS_CTL) + CW_BAR, (volatile LAS unsigned*)(F.lds + LDS_MISC));
#ifndef ONLY_PH
#define ONLY_PH -1
#endif
#define IN(k) (lo <= (k) && (k) < hi)
#ifndef SKIP_MASK
#define SKIP_MASK 0
#endif
#define INL(j) ((ONLY_PH < 0 || ONLY_PH == 1 + (j)) && !((SKIP_MASK >> (1 + (j))) & 1) && IN(g0 + (j)))
#define SEAM(k) do { if ((k) + 1 < hi) xcd_barrier(bar); } while (0)
    bf16_t* const Hb = (bf16_t*)(F.ws + WS_H); bf16_t* const Pb = (bf16_t*)(F.ws + WS_PROJ); bf16_t* const Ab = (bf16_t*)(F.ws + WS_ACT);
    float* const XC = (float*)(F.ws + WS_XC); const float* const modp = (const float*)(F.ws + WS_MOD);
    const LAS int* tstart = (const LAS int*)(F.lds + LDS_MISC) + 16;

    if ((ONLY_PH < 0 || ONLY_PH == 0) && !(SKIP_MASK & 1) && IN(0)) { p0_prologue(F); if (REP_MASK & 1) { __syncthreads(); p0_prologue(F); } SEAM(0); }
#pragma unroll 1
    for (int layer = 0; layer < DEPTH; ++layer) {
        const int g0 = 1 + NPH_LAYER * layer;
        const bool with_ctx = layer < DEPTH - 1;
        const int nrows = with_ctx ? MT : NLAT;
        if (INL(0)) { if ((REP_MASK & 2048) && layer > 0) { p_norm<0>(F, layer, layer - 1, MT, true); __syncthreads(); } p_norm<0>(F, layer, layer - 1, MT); if ((REP_MASK & 256) && layer == 0) p_norm<0>(F, layer, layer - 1, MT); SEAM(g0 + 0); }
        if (INL(1)) {
            pg8::DenseOrder S; S.init(Hb, (const bf16_t*)(F.ws + WS_WIN) + (size_t)layer * DIN * D, MT, DIN, D, F.G, (int)blockIdx.x);
            pg8::EpiProj E{Pb, (const float*)(F.ws + WS_ROPE), F.in[I_QG] + layer * HD, F.in[I_KG] + layer * HD};
            pg8::gemm_phase<pg8::EpiProj, pg8::DenseOrder, false, true>(F.lds, D, S, E);
            if (REP_MASK & 2) pg8::gemm_phase<pg8::EpiProj, pg8::DenseOrder, false, true>(F.lds, D, S, E);
            SEAM(g0 + 1);
        }
        if (INL(2)) { p4_mixers(F, layer); SEAM(g0 + 2); }
        if (INL(3)) {
            pg8::DenseOrder S; S.init(Hb, (const bf16_t*)(F.ws + WS_WOUT) + (size_t)layer * D * DMIX, nrows, D, DMIX, F.G, (int)blockIdx.x);
            pg8::EpiResid E{layer == 0 ? F.in[I_X] : F.out, layer == 0 ? F.in[I_CTX] : XC, F.out, XC, modp + (size_t)layer * 33 * (NMOD * D) + 2 * D};
            pg8::gemm_phase<pg8::EpiResid, pg8::DenseOrder, false, true>(F.lds, DMIX, S, E);
            if ((REP_MASK & 128) && layer == 0) pg8::gemm_phase<pg8::EpiResid, pg8::DenseOrder, false, true>(F.lds, DMIX, S, E);
            SEAM(g0 + 3);
        }
        if (INL(4)) { if (REP_MASK & 512) { p6_router(F, layer, nrows, false); __syncthreads(); } p6_router(F, layer, nrows); SEAM(g0 + 4); }
        if (INL(5)) {
            build_tstart(F, layer);
            pg8::MoeOrder S{Hb, (const bf16_t*)(F.ws + WS_WGU) + (size_t)layer * NE * 1024 * 1024, (size_t)1024 * 1024, D, 4, tstart, F.G, (int)blockIdx.x,
                            (const int*)(F.ws + WS_TOK), (const int*)((const unsigned*)(F.ws + WS_CTL) + CW_CNT + layer * NE)};
            pg8::EpiGlu E{Ab};
            pg8::gemm_phase<pg8::EpiGlu, pg8::MoeOrder, true, true>(F.lds, D, S, E);
            if (REP_MASK & 32) pg8::gemm_phase<pg8::EpiGlu, pg8::MoeOrder, true, true>(F.lds, D, S, E);
            SEAM(g0 + 5);
        }
        if (INL(6)) {
            build_tstart(F, layer);
            pg8::MoeOrder S{Ab, (const bf16_t*)(F.ws + WS_WD) + (size_t)layer * NE * 1024 * DE, (size_t)1024 * DE, DE, 4, tstart, F.G, (int)blockIdx.x, nullptr, nullptr};
            pg8::EpiBf16 E{Pb, D};
            pg8::gemm_phase<pg8::EpiBf16, pg8::MoeOrder, false, true>(F.lds, DE, S, E);
            if (REP_MASK & 64) pg8::gemm_phase<pg8::EpiBf16, pg8::MoeOrder, false, true>(F.lds, DE, S, E);
            SEAM(g0 + 6);
        }
    }
    if ((ONLY_PH < 0 || ONLY_PH == 8) && !((SKIP_MASK >> 8) & 1) && IN(PH_FINAL)) { p_norm<1>(F, 0, DEPTH - 1, NLAT); }
#undef IN
#undef INL
#undef SEAM
}

extern "C" void kernel_launch(void* const* d_in, const int* in_sizes, int n_in, void* d_out, int out_size, void* d_ws, size_t ws_size, hipStream_t stream) {
    static int grid = 0;
    if (grid == 0) {
        if (n_in != N_IN || out_size != NLAT * D || ws_size < WS_END) { fprintf(stderr, "kernel_launch: unexpected shapes (n_in %d out %d ws %zu); nothing launched\n", n_in, out_size, ws_size); grid = -1; return; }
        int dev = 0, cus = 0;
        if (hipGetDevice(&dev) != hipSuccess || hipDeviceGetAttribute(&cus, hipDeviceAttributeMultiprocessorCount, dev) != hipSuccess) { grid = -1; return; }
        if (hipFuncSetAttribute((const void*)hymba_fwd, hipFuncAttributeMaxDynamicSharedMemorySize, LDS_BYTES) != hipSuccess) { fprintf(stderr, "kernel_launch: hipFuncSetAttribute failed\n"); grid = -1; return; }
        int per_cu = 0;
        if (hipOccupancyMaxActiveBlocksPerMultiprocessor(&per_cu, (const void*)hymba_fwd, 512, LDS_BYTES) != hipSuccess || per_cu < 1) { fprintf(stderr, "kernel_launch: occupancy query says %d\n", per_cu); }
        (void)hipGetLastError();
        grid = cus;
    }
    if (grid < 0) return;
    (void)hipMemsetAsync((char*)d_ws + WS_CTL, 0, CTL_ZERO_BYTES, stream);
    Args a{};
    for (int i = 0; i < N_IN; ++i) a.in[i] = (const float*)d_in[i];
    a.out = (float*)d_out; a.ws = (unsigned char*)d_ws;
#if MK_ONE_LAUNCH
    a.ph_lo = 0; a.ph_hi = NPHASES;
    hipLaunchKernelGGL(hymba_fwd, dim3(grid), dim3(512), LDS_BYTES, stream, a);
#else
    for (int p = 0; p < NPHASES; ++p) { a.ph_lo = p; a.ph_hi = p + 1; hipLaunchKernelGGL(hymba_fwd, dim3(grid), dim3(512), LDS_BYTES, stream, a); }
#endif
}
```
